# Optimizing an MI355X kernel written in HIP

```python
import math
import jax
import jax.numpy as jnp
from jax import lax
import numpy as np


D_MODEL = 2048
BATCH = 1
SEQ = 16384
DEPTH = 4

HEAD_DIM = 64
BRANCH_WIDTH = D_MODEL // 4
MIX_WIDTH = 4 * BRANCH_WIDTH
A_HEADS = BRANCH_WIDTH // HEAD_DIM
DILATED_PATTERNS = ((128, 1), (512, 4), (2048, 16))
ROPE_THETA = 500000.0
ROT_DIMS = HEAD_DIM // 4
SSM_GROUP = 16
SSM_GROUPS = BRANCH_WIDTH // SSM_GROUP
SSM_STATE = 64
C_HEADS = BRANCH_WIDTH // HEAD_DIM
C_KV_HEADS = C_HEADS // 4
AXIAL_THETA = 10000.0
GRID_W = 64
D_HEADS = BRANCH_WIDTH // (2 * HEAD_DIM)
PLE_DIM = 256
BLOCK_Q = 128
NORM_EPS = 1e-6
MASK_VALUE = -1e30

SPLIT_SIZES = (
    BRANCH_WIDTH, BRANCH_WIDTH, BRANCH_WIDTH, BRANCH_WIDTH,
    BRANCH_WIDTH, BRANCH_WIDTH,
    BRANCH_WIDTH, C_KV_HEADS * HEAD_DIM, C_KV_HEADS * HEAD_DIM, BRANCH_WIDTH,
    BRANCH_WIDTH, BRANCH_WIDTH, BRANCH_WIDTH, BRANCH_WIDTH,
)
IN_COLS = sum(SPLIT_SIZES)
SPLIT_POINTS = tuple(int(c) for c in np.cumsum(SPLIT_SIZES)[:-1])

kernel_name = 'hybrid_parallel_head_encoder'


def rms_norm(x, w):
    xf = x.astype(jnp.float32)
    y = xf * lax.rsqrt(jnp.mean(xf * xf, axis=-1, keepdims=True) + NORM_EPS)
    return (y * w.astype(jnp.float32)).astype(x.dtype)


def rope_tables(pos, n_dims, theta):
    inv = theta ** (-jnp.arange(0, n_dims, 2, dtype=jnp.float32) / n_dims)
    ang = pos[:, None] * inv[None, :]
    return jnp.cos(ang), jnp.sin(ang)


def rotate(x, cos, sin):
    x1, x2 = jnp.split(x.astype(jnp.float32), 2, axis=-1)
    c = cos[None, :, None, :]
    s = sin[None, :, None, :]
    return jnp.concatenate([x1 * c - x2 * s, x1 * s + x2 * c], axis=-1).astype(x.dtype)


def partial_rope(x, cos, sin):
    return jnp.concatenate([rotate(x[..., :ROT_DIMS], cos, sin), x[..., ROT_DIMS:]], axis=-1)


def axial_rope(x, cos_r, sin_r, cos_c, sin_c):
    half = HEAD_DIM // 2
    return jnp.concatenate([rotate(x[..., :half], cos_r, sin_r),
                            rotate(x[..., half:], cos_c, sin_c)], axis=-1)


def banded_attention(q, k, v, n_side):
    L, E = q.shape[-2], q.shape[-1]
    lead = q.shape[:-2]
    bq = min(BLOCK_Q, L)
    nb = -(-L // bq)
    lp = nb * bq

    def pad(t, lo, hi):
        return jnp.pad(t, [(0, 0)] * len(lead) + [(lo, hi), (0, 0)])

    qb = pad(q, 0, lp - L).reshape(*lead, nb, bq, E)
    kw = bq + 2 * n_side
    idx = (jnp.arange(nb) * bq)[:, None] + jnp.arange(kw)[None, :]
    kb = jnp.take(pad(k, n_side, n_side + lp - L), idx, axis=-2)
    vb = jnp.take(pad(v, n_side, n_side + lp - L), idx, axis=-2)
    key_pos = idx - n_side
    q_pos = (jnp.arange(nb) * bq)[:, None] + jnp.arange(bq)[None, :]
    rel = key_pos[:, None, :] - q_pos[:, :, None]
    valid = (jnp.abs(rel) <= n_side) & (key_pos >= 0)[:, None, :] & (key_pos < L)[:, None, :]
    s = jnp.einsum('...qe,...ke->...qk', qb, kb).astype(jnp.float32) * (E ** -0.5)
    s = jnp.where(valid, s, MASK_VALUE)
    lse = jax.nn.logsumexp(s, axis=-1)
    pr = jnp.exp(s - lse[..., None]).astype(v.dtype)
    o = jnp.einsum('...qk,...ke->...qe', pr, vb)
    o = o.reshape(*lead, lp, E)[..., :L, :]
    lse = lse.reshape(*lead, lp)[..., :L]
    return o, lse


def residue_split(t, dil):
    b, h, s, e = t.shape
    return t.reshape(b, h, s // dil, dil, e).swapaxes(2, 3)


def dilated_attention(q, k, v):
    bsz, s_len, h, dh = q.shape
    qt, kt, vt = (t.transpose(0, 2, 1, 3) for t in (q, k, v))
    outs, lses = [], []
    for window, dil in DILATED_PATTERNS:
        n_side = (window // 2) // dil
        o, lse = banded_attention(residue_split(qt, dil), residue_split(kt, dil),
                                  residue_split(vt, dil), n_side)
        outs.append(o.swapaxes(2, 3).reshape(bsz, h, s_len, dh))
        lses.append(lse.swapaxes(2, 3).reshape(bsz, h, s_len))
    wts = jax.nn.softmax(jnp.stack(lses), axis=0)
    o = jnp.sum(wts[..., None] * jnp.stack(outs).astype(jnp.float32), axis=0).astype(q.dtype)
    return o.transpose(0, 2, 1, 3).reshape(bsz, s_len, h * dh)


def complex_linear_combine(e1, e2):
    a1r, a1i, b1r, b1i = e1
    a2r, a2i, b2r, b2i = e2
    return (a2r * a1r - a2i * a1i,
            a2r * a1i + a2i * a1r,
            a2r * b1r - a2i * b1i + b2r,
            a2r * b1i + a2i * b1r + b2i)


def s5_mixer(u, lam_re, lam_im, log_dt, b_re, b_im, c_re, c_im, d_skip, w_glu, b_glu):
    bsz, s_len, width = u.shape
    f32 = jnp.float32
    uf = u.astype(f32)
    ug = uf.reshape(bsz, s_len, SSM_GROUPS, SSM_GROUP)
    lr = lam_re.astype(f32)
    li = lam_im.astype(f32)
    dt = jnp.exp(log_dt.astype(f32))[..., None]
    mag = jnp.exp(lr * dt)
    ar = mag * jnp.cos(li * dt)
    ai = mag * jnp.sin(li * dt)
    den = lr * lr + li * li
    coef_re = ((ar - 1.0) * lr + ai * li) / den
    coef_im = (ai * lr - (ar - 1.0) * li) / den
    br = b_re.astype(f32)
    bi = b_im.astype(f32)
    bbar_re = coef_re[..., None] * br - coef_im[..., None] * bi
    bbar_im = coef_re[..., None] * bi + coef_im[..., None] * br
    y = d_skip.astype(f32) * uf
    for direction in range(2):
        ud = ug if direction == 0 else jnp.flip(ug, axis=1)
        bu_re = jnp.einsum('gpc,bsgc->bsgp', bbar_re[direction], ud)
        bu_im = jnp.einsum('gpc,bsgc->bsgp', bbar_im[direction], ud)
        a_re = jnp.broadcast_to(ar[direction], bu_re.shape)
        a_im = jnp.broadcast_to(ai[direction], bu_re.shape)
        _, _, xr, xi = lax.associative_scan(complex_linear_combine, (a_re, a_im, bu_re, bu_im), axis=1)
        yd = (jnp.einsum('gcp,bsgp->bsgc', c_re[direction].astype(f32), xr)
              - jnp.einsum('gcp,bsgp->bsgc', c_im[direction].astype(f32), xi))
        if direction == 1:
            yd = jnp.flip(yd, axis=1)
        y = y + yd.reshape(bsz, s_len, width)
    y = jax.nn.gelu(y)
    z = y @ w_glu.astype(f32) + b_glu.astype(f32)
    out = z[..., :width] * jax.nn.sigmoid(z[..., width:])
    return out.astype(u.dtype)


def gqa_attention(q, k, v):
    bsz, s_len, hq, dh = q.shape
    hkv = k.shape[2]
    grp = hq // hkv
    nb = s_len // BLOCK_Q
    qb = q.reshape(bsz, s_len, hkv, grp, dh).transpose(0, 2, 3, 1, 4)
    qb = jnp.moveaxis(qb.reshape(bsz, hkv, grp, nb, BLOCK_Q, dh), 3, 0)
    kt = k.transpose(0, 2, 1, 3)
    vt = v.transpose(0, 2, 1, 3)
    scale = dh ** -0.5

    def block(qblk):
        s = jnp.einsum('bhgqd,bhkd->bhgqk', qblk, kt).astype(jnp.float32) * scale
        pr = jax.nn.softmax(s, axis=-1).astype(vt.dtype)
        return jnp.einsum('bhgqk,bhkd->bhgqd', pr, vt)

    o = lax.map(block, qb)
    o = jnp.moveaxis(o, 0, 3).reshape(bsz, hkv, grp, s_len, dh).transpose(0, 3, 1, 2, 4)
    return o.reshape(bsz, s_len, hq * dh)


def diff_attention(q, k, v, lam, subln_w, lam_init):
    bsz, s_len, h, _, dh = q.shape
    nb = s_len // BLOCK_Q
    qb = q.transpose(0, 2, 3, 1, 4).reshape(bsz, h, 2, nb, BLOCK_Q, dh)
    qb = jnp.moveaxis(qb, 3, 0)
    kt = k.transpose(0, 2, 3, 1, 4)
    vt = v.transpose(0, 2, 1, 3)
    scale = dh ** -0.5

    def block(qblk):
        s = jnp.einsum('bhcqd,bhckd->bhcqk', qblk, kt).astype(jnp.float32) * scale
        pr = jax.nn.softmax(s, axis=-1)
        attn = (pr[:, :, 0] - lam * pr[:, :, 1]).astype(vt.dtype)
        return jnp.einsum('bhqk,bhkd->bhqd', attn, vt)

    o = lax.map(block, qb)
    o = jnp.moveaxis(o, 0, 2).reshape(bsz, h, s_len, 2 * dh)
    o = rms_norm(o, subln_w) * (1.0 - lam_init)
    return o.transpose(0, 2, 1, 3).reshape(bsz, s_len, h * 2 * dh)


def setup_inputs(seed: int = 0) -> dict:
    key = jax.random.key(seed)
    ks = iter(jax.random.split(key, 32))
    f32 = jnp.float32

    def nrm(shape, scale):
        return scale * jax.random.normal(next(ks), shape, f32)

    L = DEPTH
    x = nrm((BATCH, SEQ, D_MODEL), 1.0)
    p = nrm((DEPTH, BATCH, SEQ, PLE_DIM), 1.0)
    norm_w = 1.0 + nrm((L, D_MODEL), 0.02)
    w_in = nrm((L, D_MODEL, IN_COLS), D_MODEL ** -0.5)
    w_out = nrm((L, MIX_WIDTH, D_MODEL), 0.5 * MIX_WIDTH ** -0.5)
    a_q_norm = 1.0 + nrm((L, HEAD_DIM), 0.02)
    a_k_norm = 1.0 + nrm((L, HEAD_DIM), 0.02)
    s5_lambda_re = -0.5 * jnp.exp(nrm((L, 2, SSM_GROUPS, SSM_STATE), 0.05))
    s5_lambda_im = math.pi * jnp.arange(SSM_STATE, dtype=f32) + nrm((L, 2, SSM_GROUPS, SSM_STATE), 0.01)
    s5_log_dt = jax.random.uniform(next(ks), (L, 2, SSM_GROUPS), f32,
                                   minval=math.log(1e-3), maxval=math.log(1e-1))
    s5_b_re = nrm((L, 2, SSM_GROUPS, SSM_STATE, SSM_GROUP), (2 * SSM_GROUP) ** -0.5)
    s5_b_im = nrm((L, 2, SSM_GROUPS, SSM_STATE, SSM_GROUP), (2 * SSM_GROUP) ** -0.5)
    s5_c_re = nrm((L, 2, SSM_GROUPS, SSM_GROUP, SSM_STATE), (2 * SSM_STATE) ** -0.5)
    s5_c_im = nrm((L, 2, SSM_GROUPS, SSM_GROUP, SSM_STATE), (2 * SSM_STATE) ** -0.5)
    s5_d = nrm((L, BRANCH_WIDTH), 1.0)
    s5_w_glu = nrm((L, BRANCH_WIDTH, 2 * BRANCH_WIDTH), BRANCH_WIDTH ** -0.5)
    s5_b_glu = nrm((L, 2 * BRANCH_WIDTH), 0.01)
    c_q_norm = 1.0 + nrm((L, HEAD_DIM), 0.02)
    c_k_norm = 1.0 + nrm((L, HEAD_DIM), 0.02)
    d_q_norm = 1.0 + nrm((L, HEAD_DIM), 0.02)
    d_k_norm = 1.0 + nrm((L, HEAD_DIM), 0.02)
    d_lambda_q1 = nrm((L, HEAD_DIM), 0.1)
    d_lambda_k1 = nrm((L, HEAD_DIM), 0.1)
    d_lambda_q2 = nrm((L, HEAD_DIM), 0.1)
    d_lambda_k2 = nrm((L, HEAD_DIM), 0.1)
    d_subln = 1.0 + nrm((L, 2 * HEAD_DIM), 0.02)
    ple_norm_w = 1.0 + nrm((L, D_MODEL), 0.02)
    ple_gate_w = nrm((L, D_MODEL, D_MODEL), D_MODEL ** -0.5)
    ple_w = nrm((L, PLE_DIM, D_MODEL), 0.5 * PLE_DIM ** -0.5)
    return {'x': x, 'p': p, 'norm_w': norm_w, 'w_in': w_in, 'w_out': w_out,
            'a_q_norm': a_q_norm, 'a_k_norm': a_k_norm,
            's5_lambda_re': s5_lambda_re, 's5_lambda_im': s5_lambda_im, 's5_log_dt': s5_log_dt,
            's5_b_re': s5_b_re, 's5_b_im': s5_b_im, 's5_c_re': s5_c_re, 's5_c_im': s5_c_im,
            's5_d': s5_d, 's5_w_glu': s5_w_glu, 's5_b_glu': s5_b_glu,
            'c_q_norm': c_q_norm, 'c_k_norm': c_k_norm,
            'd_q_norm': d_q_norm, 'd_k_norm': d_k_norm,
            'd_lambda_q1': d_lambda_q1, 'd_lambda_k1': d_lambda_k1,
            'd_lambda_q2': d_lambda_q2, 'd_lambda_k2': d_lambda_k2, 'd_subln': d_subln,
            'ple_norm_w': ple_norm_w, 'ple_gate_w': ple_gate_w, 'ple_w': ple_w}


def reference(x, p, norm_w, w_in, w_out, a_q_norm, a_k_norm,
              s5_lambda_re, s5_lambda_im, s5_log_dt, s5_b_re, s5_b_im, s5_c_re, s5_c_im,
              s5_d, s5_w_glu, s5_b_glu, c_q_norm, c_k_norm, d_q_norm, d_k_norm,
              d_lambda_q1, d_lambda_k1, d_lambda_q2, d_lambda_k2, d_subln,
              ple_norm_w, ple_gate_w, ple_w):
    f32 = jnp.float32
    bsz, s_len = x.shape[0], x.shape[1]
    t = jnp.arange(s_len)
    cos_1d, sin_1d = rope_tables(t.astype(f32), ROT_DIMS, ROPE_THETA)
    rows = s_len // GRID_W
    row_c = (t // GRID_W - rows // 2).astype(f32)
    col_c = (t % GRID_W - GRID_W // 2).astype(f32)
    cos_r, sin_r = rope_tables(row_c, HEAD_DIM // 2, AXIAL_THETA)
    cos_c, sin_c = rope_tables(col_c, HEAD_DIM // 2, AXIAL_THETA)

    for i in range(DEPTH):
        h = rms_norm(x, norm_w[i])
        (aq, ak, av, ag, bu, bg, cq, ck, cv, cg,
         dq, dk, dv, dg) = jnp.split(h @ w_in[i], SPLIT_POINTS, axis=-1)

        aq = partial_rope(rms_norm(aq.reshape(bsz, s_len, A_HEADS, HEAD_DIM), a_q_norm[i]), cos_1d, sin_1d)
        ak = partial_rope(rms_norm(ak.reshape(bsz, s_len, A_HEADS, HEAD_DIM), a_k_norm[i]), cos_1d, sin_1d)
        a_out = dilated_attention(aq, ak, av.reshape(bsz, s_len, A_HEADS, HEAD_DIM))

        b_out = s5_mixer(bu, s5_lambda_re[i], s5_lambda_im[i], s5_log_dt[i], s5_b_re[i], s5_b_im[i],
                         s5_c_re[i], s5_c_im[i], s5_d[i], s5_w_glu[i], s5_b_glu[i])

        cq = axial_rope(rms_norm(cq.reshape(bsz, s_len, C_HEADS, HEAD_DIM), c_q_norm[i]),
                        cos_r, sin_r, cos_c, sin_c)
        ck = axial_rope(rms_norm(ck.reshape(bsz, s_len, C_KV_HEADS, HEAD_DIM), c_k_norm[i]),
                        cos_r, sin_r, cos_c, sin_c)
        c_out = gqa_attention(cq, ck, cv.reshape(bsz, s_len, C_KV_HEADS, HEAD_DIM))

        dq = partial_rope(rms_norm(dq.reshape(bsz, s_len, 2 * D_HEADS, HEAD_DIM), d_q_norm[i]),
                          cos_1d, sin_1d).reshape(bsz, s_len, D_HEADS, 2, HEAD_DIM)
        dk = partial_rope(rms_norm(dk.reshape(bsz, s_len, 2 * D_HEADS, HEAD_DIM), d_k_norm[i]),
                          cos_1d, sin_1d).reshape(bsz, s_len, D_HEADS, 2, HEAD_DIM)
        lam_init = 0.8 - 0.6 * math.exp(-0.3 * i)
        lam = (jnp.exp(jnp.sum(d_lambda_q1[i].astype(f32) * d_lambda_k1[i].astype(f32)))
               - jnp.exp(jnp.sum(d_lambda_q2[i].astype(f32) * d_lambda_k2[i].astype(f32))) + lam_init)
        d_out = diff_attention(dq, dk, dv.reshape(bsz, s_len, D_HEADS, 2 * HEAD_DIM), lam, d_subln[i], lam_init)

        mixed = jnp.concatenate([a_out * jax.nn.silu(ag), b_out * jax.nn.silu(bg),
                                 c_out * jax.nn.silu(cg), d_out * jax.nn.silu(dg)], axis=-1)
        x = x + mixed @ w_out[i]

        gate = jax.nn.sigmoid(rms_norm(x, ple_norm_w[i]) @ ple_gate_w[i])
        x = x + gate * (p[i] @ ple_w[i])
    return x
```

```cpp
#include <hip/hip_runtime.h>
#include <hip/hip_cooperative_groups.h>
#include <cstdio>
namespace cg = cooperative_groups;

#define DI __device__ __forceinline__
typedef unsigned short bf16_t;
using bf16x8 = __attribute__((ext_vector_type(8))) short;
using f32x16 = __attribute__((ext_vector_type(16))) float;
typedef __attribute__((ext_vector_type(2))) float f32x2_t;
typedef __attribute__((ext_vector_type(4))) unsigned u32x4;
typedef __attribute__((ext_vector_type(2))) __bf16 bf16x2_t;

constexpr int S = 16384;
constexpr int DM = 2048;
constexpr int NC = 6400;
constexpr int NLAYER = 4;
constexpr float LOG2E = 1.4426950408889634f;
constexpr float QSCALE = 0.125f * LOG2E;
constexpr int LDH = DM + 64;
constexpr int LDQ = 512 + 64;
constexpr int VTS = S + 64;

constexpr size_t al(size_t x) { return (x + 255) & ~(size_t)255; }
constexpr size_t OFF_WTIN = 0;
constexpr size_t OFF_WTOUT = OFF_WTIN + al((size_t)NC * LDH * 2);
constexpr size_t OFF_WTGATE = OFF_WTOUT + al((size_t)DM * LDH * 2);
constexpr size_t OFF_WTPLE = OFF_WTGATE + al((size_t)DM * LDH * 2);
constexpr size_t OFF_WTGLU = OFF_WTPLE + al((size_t)DM * 256 * 2);
constexpr size_t OFF_PBF = OFF_WTGLU + al((size_t)1024 * LDQ * 2);
constexpr size_t OFF_W1 = OFF_PBF + al((size_t)S * 256 * 2);
constexpr size_t OFF_W3 = OFF_W1 + al((size_t)32 * 256 * LDQ * 2);
constexpr size_t OFF_APT = OFF_W3 + al((size_t)32 * 512 * 1280 * 2);
constexpr size_t OFF_SC = OFF_APT + al((size_t)2 * 32 * 64 * 8);
constexpr size_t OFF_COS1 = OFF_SC + al(64);
constexpr size_t OFF_SIN1 = OFF_COS1 + al((size_t)S * 8 * 4);
constexpr size_t OFF_AXT = OFF_SIN1 + al((size_t)S * 8 * 4);
constexpr size_t OFF_H = OFF_AXT + al((size_t)(256 + 256 + 64 + 64) * 16 * 4);
constexpr size_t OFF_QA = OFF_H + al((size_t)S * LDH * 2);
constexpr size_t OFF_KA = OFF_QA + al((size_t)S * LDQ * 2);
constexpr size_t OFF_VTA = OFF_KA + al((size_t)S * LDQ * 2);
constexpr size_t OFF_QC = OFF_VTA + al((size_t)3 * 512 * VTS * 2);
constexpr size_t OFF_KC = OFF_QC + al((size_t)S * LDQ * 2);
constexpr size_t OFF_VTC = OFF_KC + al((size_t)S * 128 * 2);
constexpr size_t OFF_QD = OFF_VTC + al((size_t)128 * VTS * 2);
constexpr size_t OFF_KD = OFF_QD + al((size_t)S * LDQ * 2);
constexpr size_t OFF_VTD = OFF_KD + al((size_t)S * LDQ * 2);
constexpr size_t OFF_GATE = OFF_VTD + al((size_t)512 * VTS * 2);
constexpr size_t OFF_U = OFF_GATE + al((size_t)S * LDH * 2);
constexpr size_t OFF_XLOC = OFF_U + al((size_t)S * LDQ * 2);
constexpr size_t OFF_CIN = OFF_XLOC + al((size_t)32 * 512 * 256 * 4);
constexpr size_t OFF_DTMP = OFF_CIN + al((size_t)32 * 512 * 256 * 2);
constexpr size_t OFF_Y = OFF_DTMP + al((size_t)2 * S * 512 * 4);
constexpr size_t OFF_MIXED = OFF_Y + al((size_t)S * LDQ * 2);
constexpr size_t OFF_PE = OFF_MIXED + al((size_t)S * LDH * 2);
constexpr size_t OFF_BAR = OFF_PE + al((size_t)S * DM * 2);
constexpr size_t OFF_H2 = OFF_BAR + al(4096 * 4);
constexpr size_t OFF_RS = OFF_H2 + al((size_t)S * LDH * 2);
constexpr size_t OFF_AOA = OFF_RS + al((size_t)2 * S * 4);
constexpr size_t OFF_AOL = OFF_AOA + al((size_t)S * 512 * 4);
constexpr size_t OFF_WTOUT2 = OFF_AOL + al((size_t)S * 8 * 4);
constexpr size_t OFF_WTGATE2 = OFF_WTOUT2 + al((size_t)DM * LDH * 2);
constexpr size_t WS_TOTAL = OFF_WTGATE2 + al((size_t)DM * LDH * 2);

struct Params {
  const float* x; const float* p; const float* norm_w; const float* w_in; const float* w_out;
  const float* a_q_norm; const float* a_k_norm;
  const float* lam_re; const float* lam_im; const float* log_dt; const float* b_re; const float* b_im;
  const float* c_re; const float* c_im; const float* s5_d; const float* w_glu; const float* b_glu;
  const float* c_q_norm; const float* c_k_norm; const float* d_q_norm; const float* d_k_norm;
  const float* lq1; const float* lk1; const float* lq2; const float* lk2; const float* d_subln;
  const float* ple_norm_w; const float* ple_gate_w; const float* ple_w;
  float* out; char* ws;
};

DI int tidx() { int t = __builtin_amdgcn_workitem_id_x(); asm volatile("" : "+v"(t)); return t; }
DI unsigned pk2(float a, float b) { f32x2_t v = {a, b}; bf16x2_t r = __builtin_convertvector(v, bf16x2_t); return __builtin_bit_cast(unsigned, r); }
DI bf16_t f2bf(float a) { return (bf16_t)(pk2(a, 0.f) & 0xffffu); }
DI float bf2f(bf16_t v) { return __uint_as_float(((unsigned)v) << 16); }
DI float wave_sum(float v) { for (int o = 32; o; o >>= 1) v += __shfl_xor(v, o); return v; }
DI float wave_max(float v) { for (int o = 32; o; o >>= 1) v = fmaxf(v, __shfl_xor(v, o)); return v; }
DI f32x16 mfma(bf16x8 a, bf16x8 b, f32x16 c) { return __builtin_amdgcn_mfma_f32_32x32x16_bf16(a, b, c, 0, 0, 0); }
DI f32x16 splat16(float v) { f32x16 r; for (int i = 0; i < 16; ++i) r[i] = v; return r; }
DI uint4 pack8(const float* f) { uint4 u; u.x = pk2(f[0], f[1]); u.y = pk2(f[2], f[3]); u.z = pk2(f[4], f[5]); u.w = pk2(f[6], f[7]); return u; }
DI void unpack8(uint4 u, float* f) {
  f[0] = __uint_as_float(u.x << 16); f[1] = __uint_as_float(u.x & 0xffff0000u);
  f[2] = __uint_as_float(u.y << 16); f[3] = __uint_as_float(u.y & 0xffff0000u);
  f[4] = __uint_as_float(u.z << 16); f[5] = __uint_as_float(u.z & 0xffff0000u);
  f[6] = __uint_as_float(u.w << 16); f[7] = __uint_as_float(u.w & 0xffff0000u);
}
DI bf16x8 ld_frag(const void* p) { return *(const bf16x8*)p; }
template <int S_>
DI bf16x8 packP(const f32x16& p) {
  uint4 u; u.x = pk2(p[8 * S_], p[8 * S_ + 1]); u.y = pk2(p[8 * S_ + 2], p[8 * S_ + 3]); u.z = pk2(p[8 * S_ + 4], p[8 * S_ + 5]); u.w = pk2(p[8 * S_ + 6], p[8 * S_ + 7]);
  return __builtin_bit_cast(bf16x8, u);
}
DI float sigmoidf_(float x) { return 1.f / (1.f + __expf(-x)); }
DI float siluf_(float x) { return x / (1.f + __expf(-x)); }
DI int aperm(int r) { return 16 * ((r >> 2) & 1) + (r & 3) + 4 * (r >> 3); }
DI int kperm(int r) { return (r & 16) | (((r >> 2) & 1) << 3) | (((r >> 3) & 1) << 2) | (r & 3); }

constexpr int NT = 512;
constexpr int G_STAGE = 512 * 128;
struct GemmSeg { const bf16_t* A; long lda; int ks16; const bf16_t* B; long ldb; int K; };

DI void gemm_kloop(f32x16 (&acc)[2][4], const GemmSeg sg, int m0, int n0, char* smem) {
  const int tid = tidx(), lane = tid & 63, w = tid >> 6, wn = w & 3, wm = w >> 2;
  const int r = lane & 31, h = lane >> 5;
  const int srow = tid >> 3, kc = tid & 7;
  const bf16_t* bsrc = sg.B + (long)(n0 + srow) * sg.ldb + kc * 8;
  const bf16_t* asrc = sg.A + (long)(m0 + srow) * sg.lda + (long)(kc >> 1) * sg.ks16 + (kc & 1) * 8;
  const long bstep = 64 * sg.ldb, astep = 64 * sg.lda;
  const int lo = srow * 128 + ((kc ^ ((srow >> 1) & 7)) * 16);
  const int nk = sg.K >> 6;
  u32x4 st[8];
#define G_LOAD(KT) { const int k0_ = (KT) << 6; const long ka_ = (long)(k0_ >> 4) * sg.ks16; \
    st[0] = *(const u32x4*)(bsrc + k0_); st[1] = *(const u32x4*)(bsrc + bstep + k0_); \
    st[2] = *(const u32x4*)(bsrc + 2 * bstep + k0_); st[3] = *(const u32x4*)(bsrc + 3 * bstep + k0_); \
    st[4] = *(const u32x4*)(asrc + ka_); st[5] = *(const u32x4*)(asrc + astep + ka_); \
    st[6] = *(const u32x4*)(asrc + 2 * astep + ka_); st[7] = *(const u32x4*)(asrc + 3 * astep + ka_); }
#define G_WRITE(BUF) { char* d_ = smem + (BUF) * G_STAGE + lo; \
    *(u32x4*)(d_) = st[0]; *(u32x4*)(d_ + 64 * 128) = st[1]; *(u32x4*)(d_ + 128 * 128) = st[2]; *(u32x4*)(d_ + 192 * 128) = st[3]; \
    *(u32x4*)(d_ + 256 * 128) = st[4]; *(u32x4*)(d_ + 320 * 128) = st[5]; *(u32x4*)(d_ + 384 * 128) = st[6]; *(u32x4*)(d_ + 448 * 128) = st[7]; }
  const int woff = (wn * 64 + aperm(r) + 16 * ((r >> 2) & 1)) * 128;
  const int aoff = (256 + wm * 128 + r) * 128;
  const int wsw = ((r >> 1) & 1) + 2 * (r >> 3);
  const int asw = (r >> 1) & 7;
  G_LOAD(0)
  __syncthreads();
  G_WRITE(0)
  G_LOAD(1)
  __syncthreads();
#define G_PART(P_, KT, BUF) { const int k0_ = (KT) << 6; const long ka_ = (long)(k0_ >> 4) * sg.ks16; char* d_ = smem + (BUF) * G_STAGE + lo; \
    *(u32x4*)(d_ + (P_) * 64 * 128) = st[P_]; *(u32x4*)(d_ + (256 + (P_) * 64) * 128) = st[4 + (P_)]; \
    st[P_] = *(const u32x4*)(bsrc + (P_) * bstep + k0_); st[4 + (P_)] = *(const u32x4*)(asrc + (P_) * astep + ka_); }
  for (int kt = 0; kt < nk; ++kt) {
    const int kn = kt + 2 < nk ? kt + 2 : nk - 1;
    const char* sb = smem + (kt & 1) * G_STAGE;
#pragma unroll
    for (int ks = 0; ks < 4; ++ks) {
      bf16x8 wf[2], af[4];
#pragma unroll
      for (int tau = 0; tau < 2; ++tau) wf[tau] = ld_frag(sb + woff + tau * 16 * 128 + (((ks * 2 + h) ^ wsw) * 16));
#pragma unroll
      for (int mt = 0; mt < 4; ++mt) af[mt] = ld_frag(sb + aoff + mt * 32 * 128 + (((ks * 2 + h) ^ asw) * 16));
#pragma unroll
      for (int tau = 0; tau < 2; ++tau)
#pragma unroll
        for (int mt = 0; mt < 4; ++mt) acc[tau][mt] = mfma(wf[tau], af[mt], acc[tau][mt]);
      if (ks == 0) G_PART(0, kn, (kt + 1) & 1)
      if (ks == 1) G_PART(1, kn, (kt + 1) & 1)
      if (ks == 2) G_PART(2, kn, (kt + 1) & 1)
      if (ks == 3) G_PART(3, kn, (kt + 1) & 1)
    }
    __syncthreads();
  }
#undef G_PART
#undef G_LOAD
#undef G_WRITE
}

DI void zero_acc(f32x16 (&acc)[2][4]) {
#pragma unroll
  for (int a = 0; a < 2; ++a)
#pragma unroll
    for (int b = 0; b < 4; ++b) acc[a][b] = splat16(0.f);
}

DI void transpose_task(const float* src, int N, int ldd, bf16_t* dst, int tile, int ntn, bool glu, char* smem, const float* kscale = nullptr) {
  float* tl = (float*)smem;
  const int tid = tidx();
  const int kt = tile / ntn, nt = tile - kt * ntn, k0 = kt * 64, n0 = nt * 64;
  __syncthreads();
#pragma unroll
  for (int j = 0; j < 2; ++j) {
    const int k = (tid >> 4) + 32 * j, n4 = (tid & 15) * 4;
    const float4 v = *(const float4*)(src + (long)(k0 + k) * N + n0 + n4);
    const float sc = kscale ? kscale[k0 + k] : 1.f;
    tl[k * 65 + n4] = v.x * sc; tl[k * 65 + n4 + 1] = v.y * sc; tl[k * 65 + n4 + 2] = v.z * sc; tl[k * 65 + n4 + 3] = v.w * sc;
  }
  __syncthreads();
  {
    const int n = tid >> 3, k8 = (tid & 7) * 8;
    float f[8];
#pragma unroll
    for (int e = 0; e < 8; ++e) f[e] = tl[(k8 + e) * 65 + n];
    const int nsrc = n0 + n;
    const int ndst = glu ? (32 * ((nsrc & 511) >> 4) + 16 * (nsrc >> 9) + (nsrc & 15)) : nsrc;
    *(uint4*)(dst + (long)ndst * ldd + k0 + k8) = pack8(f);
  }
}

DI void sincos_rev(double ang, float& cs, float& sn) {
  const double rev = ang * 0.15915494309189535;
  const float fr = (float)(rev - rint(rev));
  cs = __builtin_amdgcn_cosf(fr); sn = __builtin_amdgcn_sinf(fr);
}
__constant__ double ROPE1_INV[8] = {1.0, 0.19392274474868576, 0.03760603093086393, 0.007292664737217109, 0.001414213562373095, 0.0002742481756762073, 5.318295896944988e-05, 1.031338537721246e-05};
__constant__ double AXIAL_INV[16] = {1.0, 0.5623413251903491, 0.31622776601683794, 0.1778279410038923, 0.1, 0.05623413251903491, 0.03162277660168379, 0.01778279410038923,
                                     0.01, 0.005623413251903491, 0.0031622776601683794, 0.001778279410038923, 0.001, 0.0005623413251903491, 0.00031622776601683794, 0.0001778279410038923};

DI void s5prep_task(const Params& P, int li, int g, int dir, int q, char* smem) {
  float2* Apow = (float2*)smem;
  float2* Bbar = Apow + 33 * 64;
  float2* Cc = Bbar + 64 * 16;
  float* Kt = (float*)(Cc + 16 * 64);
  const int tid = tidx();
  const long gp = (((long)li * 2 + dir) * 32 + g) * 64;
  const float dtf = expf(P.log_dt[(li * 2 + dir) * 32 + g]);
  const double dt = (double)dtf;
  bf16_t* W1 = (bf16_t*)(P.ws + OFF_W1) + (long)g * 256 * LDQ;
  bf16_t* W3 = (bf16_t*)(P.ws + OFF_W3) + (long)g * 512 * 1280;
  float2* apT = (float2*)(P.ws + OFF_APT);
  const float* cre = P.c_re + (((long)li * 2 + dir) * 32 + g) * 16 * 64;
  const float* cim = P.c_im + (((long)li * 2 + dir) * 32 + g) * 16 * 64;
  __syncthreads();
  for (int idx = tid; idx < 33 * 64; idx += NT) {
    const int e = idx >> 6, p = idx & 63;
    const double lr = P.lam_re[gp + p], lim = P.lam_im[gp + p];
    const float mag = expf((float)((double)e * lr * dt));
    float cs, sn; sincos_rev((double)e * lim * dt, cs, sn);
    Apow[idx] = make_float2(mag * cs, mag * sn);
  }
  for (int idx = tid; idx < 64 * 16; idx += NT) {
    const int p = idx >> 4, c = idx & 15;
    const double lr = P.lam_re[gp + p], lim = P.lam_im[gp + p];
    float cs, sn; sincos_rev(lim * dt, cs, sn);
    const double mag = (double)expf((float)(lr * dt)), ar = mag * cs, ai = mag * sn;
    const double den = lr * lr + lim * lim;
    const double cr = ((ar - 1.0) * lr + ai * lim) / den, ci = (ai * lr - (ar - 1.0) * lim) / den;
    const double br = P.b_re[(gp + p) * 16 + c], bi = P.b_im[(gp + p) * 16 + c];
    Bbar[idx] = make_float2((float)(cr * br - ci * bi), (float)(cr * bi + ci * br));
    Cc[idx] = make_float2(cre[idx], cim[idx]);
  }
  __syncthreads();
  if (q == 0 && tid < 64) apT[(dir * 32 + g) * 64 + tid] = Apow[32 * 64 + tid];
  for (int idx = tid; idx < 2048; idx += NT) {
    const int dl = 8 * q + (idx >> 8), co = (idx >> 4) & 15, ci = idx & 15;
    float a = 0.f;
    for (int p = 0; p < 64; ++p) {
      const float2 ap = Apow[dl * 64 + p];
      const float2 cc = Cc[co * 64 + p];
      const float gr = cc.x * ap.x - cc.y * ap.y, gi = cc.x * ap.y + cc.y * ap.x;
      const float2 b = Bbar[p * 16 + ci];
      a += gr * b.x - gi * b.y;
    }
    Kt[idx] = a;
  }
  __syncthreads();
  for (int ch = tid; ch < 128 * 16; ch += NT) {
    const int row = ch >> 4, kc = 16 * q + (ch & 15), part = row >> 6, p = row & 63, j = kc >> 1, c0 = (kc & 1) * 8;
    const int e = dir == 0 ? 31 - j : j;
    const float2 a = Apow[e * 64 + p];
    float f[8];
#pragma unroll
    for (int u = 0; u < 8; ++u) {
      const float2 b = Bbar[p * 16 + c0 + u];
      f[u] = part == 0 ? (a.x * b.x - a.y * b.y) : (a.x * b.y + a.y * b.x);
    }
    *(uint4*)(W1 + (long)(dir * 128 + row) * LDQ + kc * 8) = pack8(f);
  }
  for (int ch = tid; ch < 512 * 64; ch += NT) {
    const int n = ch >> 6, kc = ch & 63, jo = n >> 4, co = n & 15, ji = kc >> 1, ci0 = (kc & 1) * 8;
    const int dl = dir == 0 ? jo - ji : ji - jo;
    const bool mine = dl < 0 ? (q == 0) : ((dl >> 3) == q);
    if (mine) {
      float f[8];
#pragma unroll
      for (int u = 0; u < 8; ++u) {
        float v = 0.f;
        if (dl >= 0) {
          v = Kt[(dl & 7) * 256 + co * 16 + ci0 + u];
          if (dir == 0 && dl == 0 && co == ci0 + u) v += P.s5_d[li * 512 + g * 16 + co];
        }
        f[u] = v;
      }
      *(uint4*)(W3 + (long)n * 1280 + dir * 512 + kc * 8) = pack8(f);
    }
  }
  for (int ch = tid; ch < 128 * 16; ch += NT) {
    const int n = 128 * q + (ch >> 4), pc = ch & 15, part = pc >> 3, p0 = (pc & 7) * 8, jo = n >> 4, co = n & 15;
    const int e = dir == 0 ? jo + 1 : 32 - jo;
    float f[8];
#pragma unroll
    for (int u = 0; u < 8; ++u) {
      const int p = p0 + u;
      const float2 a = Apow[e * 64 + p];
      const float2 cc = Cc[co * 64 + p];
      const float gr = cc.x * a.x - cc.y * a.y, gi = cc.x * a.y + cc.y * a.x;
      f[u] = part == 0 ? gr : -gi;
    }
    *(uint4*)(W3 + (long)n * 1280 + 1024 + dir * 128 + part * 64 + p0) = pack8(f);
  }
}

DI void cvt_rows(const float* xs, bf16_t* hb, float* rs, int row0) {
  const int lane = tidx() & 63, w = tidx() >> 6;
  const int row = row0 + w;
  const float4* xr = (const float4*)(xs + (long)row * DM);
  float ss = 0.f;
#pragma unroll
  for (int j = 0; j < 8; ++j) {
    const float4 v = xr[lane + 64 * j];
    ss += v.x * v.x + v.y * v.y + v.z * v.z + v.w * v.w;
    uint2 o; o.x = pk2(v.x, v.y); o.y = pk2(v.z, v.w);
    *(uint2*)(hb + (long)row * LDH + (lane + 64 * j) * 4) = o;
  }
  ss = wave_sum(ss);
  if (lane == 0) rs[row] = ss;
}

DI void phase1(const Params& P, int li, char* smem) {
  const int tid = tidx();
  bf16_t* hb = (bf16_t*)(P.ws + OFF_H);
  constexpr int T0 = 256, T1 = T0 + 3200, T2 = T1 + 1024, T3 = T2 + 1024, T4 = T3 + 128, T5 = T4 + 128;
  constexpr int T6 = T5 + 2048, T7 = T6 + 1024, T8 = T7 + 1, T9 = T8 + 64;
  const int ntask = li == 0 ? T9 : T8;
  for (int t = blockIdx.x; t < ntask; t += gridDim.x) {
    if (t < T0) s5prep_task(P, li, t >> 3, (t >> 2) & 1, t & 3, smem);
    else if (t < T1) transpose_task(P.w_in + (long)li * DM * NC, NC, LDH, (bf16_t*)(P.ws + OFF_WTIN), t - T0, 100, false, smem, P.norm_w + li * DM);
    else if (t < T2) { if (li == 0) transpose_task(P.w_out, DM, LDH, (bf16_t*)(P.ws + OFF_WTOUT), t - T1, 32, false, smem); }
    else if (t < T3) { if (li == 0) transpose_task(P.ple_gate_w, DM, LDH, (bf16_t*)(P.ws + OFF_WTGATE), t - T2, 32, false, smem, P.ple_norm_w); }
    else if (t < T4) transpose_task(P.ple_w + (long)li * 256 * DM, DM, 256, (bf16_t*)(P.ws + OFF_WTPLE), t - T3, 32, false, smem);
    else if (t < T5) transpose_task(P.w_glu + (long)li * 512 * 1024, 1024, LDQ, (bf16_t*)(P.ws + OFF_WTGLU), t - T4, 16, true, smem);
    else if (t < T6) { if (li == 0) cvt_rows(P.x, hb, (float*)(P.ws + OFF_RS), (t - T5) * 8); }
    else if (t < T7) {
      const float4* ps = (const float4*)(P.p + (long)li * S * 256) + (long)(t - T6) * 1024;
      uint2* pd = (uint2*)(P.ws + OFF_PBF) + (long)(t - T6) * 1024;
#pragma unroll
      for (int j = 0; j < 2; ++j) { const float4 v = ps[tid + NT * j]; uint2 o; o.x = pk2(v.x, v.y); o.y = pk2(v.z, v.w); pd[tid + NT * j] = o; }
    } else if (t < T8) {
      if (tid < 64) {
        float* sc = (float*)(P.ws + OFF_SC);
        const float mqa = wave_max(fabsf(P.a_q_norm[li * 64 + tid])), mka = wave_max(fabsf(P.a_k_norm[li * 64 + tid]));
        const float mqc = wave_max(fabsf(P.c_q_norm[li * 64 + tid])), mkc = wave_max(fabsf(P.c_k_norm[li * 64 + tid]));
        const float mqd = wave_max(fabsf(P.d_q_norm[li * 64 + tid])), mkd = wave_max(fabsf(P.d_k_norm[li * 64 + tid]));
        const float s1 = wave_sum(P.lq1[li * 64 + tid] * P.lk1[li * 64 + tid]);
        const float s2 = wave_sum(P.lq2[li * 64 + tid] * P.lk2[li * 64 + tid]);
        if (tid == 0) {
          sc[0] = 8.f * LOG2E * mqa * mka; sc[1] = 8.f * LOG2E * mqc * mkc; sc[2] = 8.f * LOG2E * mqd * mkd;
          const float lam_init = 0.8f - 0.6f * expf(-0.3f * (float)li);
          sc[3] = expf(s1) - expf(s2) + lam_init; sc[4] = lam_init;
        }
      }
    } else {
      float* c1 = (float*)(P.ws + OFF_COS1); float* s1 = (float*)(P.ws + OFF_SIN1);
      float* ax = (float*)(P.ws + OFF_AXT);
      const int b = t - T8;
      for (int idx = b * 2048 + tid; idx < (b + 1) * 2048; idx += NT) {
        const int tt = idx >> 3, i = idx & 7;
        float cs, sn; sincos_rev((double)tt * ROPE1_INV[i], cs, sn);
        c1[idx] = cs; s1[idx] = sn;
      }
      if (b == 0) {
        for (int idx = tid; idx < 256 * 16; idx += NT) {
          float cs, sn; sincos_rev((double)((idx >> 4) - 128) * AXIAL_INV[idx & 15], cs, sn);
          ax[idx] = cs; ax[4096 + idx] = sn;
        }
        for (int idx = tid; idx < 64 * 16; idx += NT) {
          float cs, sn; sincos_rev((double)((idx >> 4) - 32) * AXIAL_INV[idx & 15], cs, sn);
          ax[8192 + idx] = cs; ax[8192 + 1024 + idx] = sn;
        }
      }
    }
  }
}

DI void rows_bf16_store(char* smem, const float* v, bf16_t* dst0, long ld) {
  const int lane = tidx() & 63, r = lane & 31, h = lane >> 5;
  char* strip = smem + (tidx() >> 6) * (32 * 144);
#pragma unroll
  for (int q = 0; q < 4; ++q) *(uint4*)(strip + r * 144 + h * 64 + q * 16) = pack8(v + 8 * q);
#pragma unroll
  for (int j = 0; j < 4; ++j) {
    const int row = (lane >> 3) + 8 * j, ch = lane & 7;
    *(uint4*)(dst0 + (long)row * ld + ch * 8) = *(const uint4*)(strip + row * 144 + ch * 16);
  }
}

DI void rows_bf16_store_acc(char* smem, const f32x16& a0, const f32x16& a1, bf16_t* dst0, long ld) {
  const int lane = tidx() & 63, r = lane & 31, h = lane >> 5;
  char* strip = smem + (tidx() >> 6) * (32 * 144);
  *(bf16x8*)(strip + r * 144 + h * 64) = packP<0>(a0); *(bf16x8*)(strip + r * 144 + h * 64 + 16) = packP<1>(a0);
  *(bf16x8*)(strip + r * 144 + h * 64 + 32) = packP<0>(a1); *(bf16x8*)(strip + r * 144 + h * 64 + 48) = packP<1>(a1);
#pragma unroll
  for (int j = 0; j < 4; ++j) {
    const int row = (lane >> 3) + 8 * j, ch = lane & 7;
    *(uint4*)(dst0 + (long)row * ld + ch * 8) = *(const uint4*)(strip + row * 144 + ch * 16);
  }
}

template <int DIL>
DI void vt_store(char* smem, const f32x16 (&acc)[2][4], const float (&rin)[4], bf16_t* img  , int tbase) {
  const int lane = tidx() & 63, r = lane & 31, h = lane >> 5;
  bf16_t* strip = (bf16_t*)(smem + (tidx() >> 6) * 16384);
#pragma unroll
  for (int mt = 0; mt < 4; ++mt) {
    const int tl = mt * 32 + r, pp = (tl % DIL) * (128 / DIL) + tl / DIL;
#pragma unroll
    for (int tau = 0; tau < 2; ++tau)
#pragma unroll
      for (int i = 0; i < 16; ++i) strip[(32 * h + 16 * tau + i) * 128 + pp] = f2bf(acc[tau][mt][i] * rin[mt]);
  }
#pragma unroll 4
  for (int j = 0; j < 16; ++j) {
    const int c = lane + 64 * j, row = c >> 4, p0 = (c & 15) * 8;
    const int rho = p0 / (128 / DIL), o = p0 % (128 / DIL);
    *(uint4*)(img + (long)row * VTS + (long)rho * (S / DIL) + tbase / DIL + o) = *(const uint4*)(strip + row * 128 + p0);
  }
}

DI void inproj_epilogue(const Params& P, int li, f32x16 (&acc)[2][4], int mbase, int nbase, char* smem) {
  const int lane = tidx() & 63, r = lane & 31, h = lane >> 5;
  char* ws = P.ws;
  int kind; bf16_t* dst = nullptr; int ld = 0, col = 0; const float* nw = nullptr; float qs = 1.f;
  if (nbase < 512) { kind = 0; dst = (bf16_t*)(ws + OFF_QA); ld = LDQ; col = nbase; nw = P.a_q_norm + li * 64; qs = QSCALE; }
  else if (nbase < 1024) { kind = 0; dst = (bf16_t*)(ws + OFF_KA); ld = LDQ; col = nbase - 512; nw = P.a_k_norm + li * 64; }
  else if (nbase < 1536) { kind = 3; dst = (bf16_t*)(ws + OFF_VTA); col = nbase - 1024; }
  else if (nbase < 2048) { kind = 4; col = nbase - 1536; }
  else if (nbase < 2560) { kind = 5; col = nbase - 2048; }
  else if (nbase < 3072) { kind = 4; col = 512 + nbase - 2560; }
  else if (nbase < 3584) { kind = 1; dst = (bf16_t*)(ws + OFF_QC); ld = LDQ; col = nbase - 3072; nw = P.c_q_norm + li * 64; qs = QSCALE; }
  else if (nbase < 3712) { kind = 1; dst = (bf16_t*)(ws + OFF_KC); ld = 128; col = nbase - 3584; nw = P.c_k_norm + li * 64; }
  else if (nbase < 3840) { kind = 2; dst = (bf16_t*)(ws + OFF_VTC); col = nbase - 3712; }
  else if (nbase < 4352) { kind = 4; col = 1024 + nbase - 3840; }
  else if (nbase < 4864) { kind = 0; dst = (bf16_t*)(ws + OFF_QD); ld = LDQ; col = nbase - 4352; nw = P.d_q_norm + li * 64; qs = QSCALE; }
  else if (nbase < 5376) { kind = 0; dst = (bf16_t*)(ws + OFF_KD); ld = LDQ; col = nbase - 4864; nw = P.d_k_norm + li * 64; }
  else if (nbase < 5888) { kind = 2; dst = (bf16_t*)(ws + OFF_VTD); col = nbase - 5376; }
  else { kind = 4; col = 1536 + nbase - 5888; }

  if (kind == 2 || kind == 3) {
    float rinv4[4];
#pragma unroll
    for (int mt = 0; mt < 4; ++mt) rinv4[mt] = rsqrtf(((const float*)(ws + OFF_RS))[mbase + mt * 32 + r] * (1.f / DM) + 1e-6f);
    vt_store<1>(smem, acc, rinv4, dst + (long)col * VTS, mbase);
    if (kind == 3) {
      vt_store<4>(smem, acc, rinv4, dst + (long)(512 + col) * VTS, mbase);
      vt_store<16>(smem, acc, rinv4, dst + (long)(1024 + col) * VTS, mbase);
    }
    return;
  }
#pragma unroll
  for (int mt = 0; mt < 4; ++mt) {
    const int t = mbase + mt * 32 + r;
    float v[32];
    const float rin = rsqrtf(((const float*)(ws + OFF_RS))[t] * (1.f / DM) + 1e-6f);
#pragma unroll
    for (int i = 0; i < 16; ++i) { v[i] = acc[0][mt][i] * rin; v[16 + i] = acc[1][mt][i] * rin; }
    if (kind <= 1) {
      float ss = 0.f;
#pragma unroll
      for (int i = 0; i < 32; ++i) ss += v[i] * v[i];
      ss += __shfl_xor(ss, 32);
      const float rinv = rsqrtf(ss * (1.f / 64.f) + 1e-6f);
#pragma unroll
      for (int i = 0; i < 32; ++i) v[i] *= rinv * nw[32 * h + i];
      if (kind == 0) {
        if (h == 0) {
          const float* cs = (const float*)(ws + OFF_COS1) + (long)t * 8;
          const float* sn = (const float*)(ws + OFF_SIN1) + (long)t * 8;
#pragma unroll
          for (int i = 0; i < 8; ++i) {
            const float c = cs[i], s = sn[i], x1 = v[i], x2 = v[i + 8];
            v[i] = x1 * c - x2 * s; v[i + 8] = x1 * s + x2 * c;
          }
        }
      } else {
        const float* ax = (const float*)(ws + OFF_AXT);
        const float* cs = h == 0 ? ax + (t >> 6) * 16 : ax + 8192 + (t & 63) * 16;
        const float* sn = h == 0 ? ax + 4096 + (t >> 6) * 16 : ax + 8192 + 1024 + (t & 63) * 16;
#pragma unroll
        for (int i = 0; i < 16; ++i) {
          const float c = cs[i], s = sn[i], x1 = v[i], x2 = v[i + 16];
          v[i] = x1 * c - x2 * s; v[i + 16] = x1 * s + x2 * c;
        }
      }
#pragma unroll
      for (int i = 0; i < 32; ++i) v[i] *= qs;
      rows_bf16_store(smem, v, dst + (long)(mbase + mt * 32) * ld + col, ld);
    } else if (kind == 4) {
#pragma unroll
      for (int i = 0; i < 32; ++i) v[i] = siluf_(v[i]);
      rows_bf16_store(smem, v, (bf16_t*)(ws + OFF_GATE) + (long)(mbase + mt * 32) * LDH + col, LDH);
    } else {
      rows_bf16_store(smem, v, (bf16_t*)(ws + OFF_U) + (long)(mbase + mt * 32) * LDQ + col, LDQ);
    }
  }
}

DI void pe_tile(const Params& P, int tt, char* smem) {
  const int lane = tidx() & 63, w = tidx() >> 6, wn = w & 3, wm = w >> 2, r = lane & 31, h = lane >> 5;
  const int nt = tt >> 6, mt = tt & 63;
  f32x16 acc[2][4]; zero_acc(acc);
  GemmSeg sg{(const bf16_t*)(P.ws + OFF_PBF), 256, 16, (const bf16_t*)(P.ws + OFF_WTPLE), 256, 256};
  gemm_kloop(acc, sg, mt * 256, nt * 256, smem);
  bf16_t* pe = (bf16_t*)(P.ws + OFF_PE);
#pragma unroll
  for (int m4 = 0; m4 < 4; ++m4) {
    char* strip = smem + w * (32 * 144);
    *(bf16x8*)(strip + r * 144 + h * 64) = packP<0>(acc[0][m4]); *(bf16x8*)(strip + r * 144 + h * 64 + 16) = packP<1>(acc[0][m4]);
    *(bf16x8*)(strip + r * 144 + h * 64 + 32) = packP<0>(acc[1][m4]); *(bf16x8*)(strip + r * 144 + h * 64 + 48) = packP<1>(acc[1][m4]);
    bf16_t* dst0 = pe + (long)(mt * 256 + wm * 128 + m4 * 32) * DM + nt * 256 + wn * 64;
#pragma unroll
    for (int j = 0; j < 4; ++j) {
      const int row = (lane >> 3) + 8 * j, ch = lane & 7;
      *(uint4*)(dst0 + (long)row * DM + ch * 8) = *(const uint4*)(strip + row * 144 + ch * 16);
    }
  }
}

DI void phase2(const Params& P, int li, char* smem) {
  const int w = tidx() >> 6, wn = w & 3, wm = w >> 2;
  for (int t = blockIdx.x; t < 64 * 25; t += gridDim.x) {
    const int nt = t >> 6, mt = t & 63;
    f32x16 acc[2][4]; zero_acc(acc);
    GemmSeg sg{(const bf16_t*)(P.ws + OFF_H), LDH, 16, (const bf16_t*)(P.ws + OFF_WTIN), LDH, DM};
    gemm_kloop(acc, sg, mt * 256, nt * 256, smem);
    inproj_epilogue(P, li, acc, mt * 256 + wm * 128, nt * 256 + wn * 64, smem);
  }
  const int b0 = gridDim.x == 256 ? 64 : 0, nb = gridDim.x - b0;
  if ((int)blockIdx.x >= b0) {
    for (int pt = blockIdx.x - b0; pt < 512; pt += nb) pe_tile(P, pt, smem);
    if (li + 1 < NLAYER) {
      const int ln = li + 1;
      bf16_t* wo = (bf16_t*)(P.ws + ((ln & 1) ? OFF_WTOUT2 : OFF_WTOUT));
      bf16_t* wg = (bf16_t*)(P.ws + ((ln & 1) ? OFF_WTGATE2 : OFF_WTGATE));
      for (int tt = blockIdx.x - b0; tt < 2048; tt += nb) {
        if (tt < 1024) transpose_task(P.w_out + (long)ln * DM * DM, DM, LDH, wo, tt, 32, false, smem);
        else transpose_task(P.ple_gate_w + (long)ln * DM * DM, DM, LDH, wg, tt - 1024, 32, false, smem, P.ple_norm_w + ln * DM);
      }
    }
  }
}


constexpr int EPI_PITCH = 68;
DI float* epi_strip(char* smem) { return (float*)smem + (tidx() >> 6) * (32 * EPI_PITCH); }
DI void epi_park(float* strip, const f32x16& a0, const f32x16& a1) {
  const int lane = tidx() & 63, r = lane & 31, h = lane >> 5;
  float* d = strip + r * EPI_PITCH + 32 * h;
#pragma unroll
  for (int q = 0; q < 4; ++q) {
    *(float4*)(d + 4 * q) = make_float4(a0[4 * q], a0[4 * q + 1], a0[4 * q + 2], a0[4 * q + 3]);
    *(float4*)(d + 16 + 4 * q) = make_float4(a1[4 * q], a1[4 * q + 1], a1[4 * q + 2], a1[4 * q + 3]);
  }
}

DI void epi_park_o(float* strip, const f32x16& o0, const f32x16& o1, float sc) {
  const int lane = tidx() & 63, r = lane & 31, h = lane >> 5;
  float* d = strip + r * EPI_PITCH + 16 * h;
#pragma unroll
  for (int q = 0; q < 4; ++q) {
    *(float4*)(d + 4 * q) = make_float4(o0[4 * q] * sc, o0[4 * q + 1] * sc, o0[4 * q + 2] * sc, o0[4 * q + 3] * sc);
    *(float4*)(d + 32 + 4 * q) = make_float4(o1[4 * q] * sc, o1[4 * q + 1] * sc, o1[4 * q + 2] * sc, o1[4 * q + 3] * sc);
  }
}

template <int QT, int DT, bool SHIFT>
DI void flash_run(f32x16 (&O)[QT][DT], float (&ls)[QT], const bf16_t* Qp, int ldq, const bf16_t* Kp, int ldk, const bf16_t* Vtp,
                  float negc, char* smem) {
  constexpr int STG = 9216 + DT * 32 * 144;
  const int tid = tidx(), lane = tid & 63, w = tid >> 6, r = lane & 31, h = lane >> 5;
  bf16x8 qf[QT][4];
#pragma unroll
  for (int qt = 0; qt < QT; ++qt)
#pragma unroll
    for (int kk = 0; kk < 4; ++kk) qf[qt][kk] = ld_frag(Qp + (long)(w * (32 * QT) + qt * 32 + r) * ldq + kk * 16 + 8 * h);
#pragma unroll
  for (int qt = 0; qt < QT; ++qt) {
    ls[qt] = 0.f;
#pragma unroll
    for (int dt = 0; dt < DT; ++dt) O[qt][dt] = splat16(0.f);
  }
  u32x4 sk[1], sv[DT / 2];
  const int srow = tid >> 3, skc = tid & 7;
  const bf16_t* ksrc = Kp + (long)srow * ldk + skc * 8;
  const bf16_t* vsrc = Vtp + (long)srow * VTS + skc * 8;
  const int slo = srow * 144 + skc * 16;
  const int koff = kperm(r) * 144 + h * 16;
  const int voff = 9216 + aperm(r) * 144 + h * 16;
  sk[0] = *(const u32x4*)(ksrc);
#pragma unroll
  for (int j = 0; j < DT / 2; ++j) sv[j] = *(const u32x4*)(vsrc + (long)(64 * j) * VTS);
  __syncthreads();
  *(u32x4*)(smem + slo) = sk[0];
#pragma unroll
  for (int j = 0; j < DT / 2; ++j) *(u32x4*)(smem + 9216 + slo + j * 64 * 144) = sv[j];
  sk[0] = *(const u32x4*)(ksrc + (long)64 * ldk);
#pragma unroll
  for (int j = 0; j < DT / 2; ++j) sv[j] = *(const u32x4*)(vsrc + (long)(64 * j) * VTS + 64);
  __syncthreads();
  constexpr int NKT = S / 64;
  for (int kt = 0; kt < NKT; ++kt) {
    char* db = smem + ((kt + 1) & 1) * STG;
    const int key0 = (kt + 2 < NKT ? kt + 2 : NKT - 1) * 64;
    const char* sb = smem + (kt & 1) * STG;
#pragma unroll
    for (int ksub = 0; ksub < 2; ++ksub) {
      bf16x8 kf[4], vf[DT][2];
#pragma unroll
      for (int kk = 0; kk < 4; ++kk) kf[kk] = ld_frag(sb + koff + ksub * 32 * 144 + kk * 32);
#pragma unroll
      for (int dt = 0; dt < DT; ++dt)
#pragma unroll
        for (int s2 = 0; s2 < 2; ++s2) vf[dt][s2] = ld_frag(sb + voff + dt * 32 * 144 + (ksub * 32 + 16 * s2) * 2);
      __builtin_amdgcn_sched_barrier(0);
      bf16x8 pf[QT][2];
#pragma unroll
      for (int qt = 0; qt < QT; ++qt) {
        f32x16 sx = splat16(SHIFT ? negc : 0.f);
#pragma unroll
        for (int kk = 0; kk < 4; ++kk) sx = mfma(kf[kk], qf[qt][kk], sx);
        float lsum = 0.f;
#pragma unroll
        for (int e = 0; e < 16; ++e) { sx[e] = __builtin_amdgcn_exp2f(sx[e]); lsum += sx[e]; }
        ls[qt] += lsum;
        pf[qt][0] = packP<0>(sx); pf[qt][1] = packP<1>(sx);
      }
      if (ksub == 0) {
        *(u32x4*)(db + slo) = sk[0];
        sk[0] = *(const u32x4*)(ksrc + (long)key0 * ldk);
      } else {
#pragma unroll
        for (int j = 0; j < DT / 2; ++j) *(u32x4*)(db + 9216 + slo + j * 64 * 144) = sv[j];
#pragma unroll
        for (int j = 0; j < DT / 2; ++j) sv[j] = *(const u32x4*)(vsrc + (long)(64 * j) * VTS + key0);
      }
#pragma unroll
      for (int dt = 0; dt < DT; ++dt)
#pragma unroll
        for (int s2 = 0; s2 < 2; ++s2)
#pragma unroll
          for (int qt = 0; qt < QT; ++qt) O[qt][dt] = mfma(vf[dt][s2], pf[qt][s2], O[qt][dt]);
    }
    __syncthreads();
  }
}

DI void attn_c_task(const Params& P, int task, char* smem) {
  const int hq = task >> 5, qb = task & 31, q0 = qb * 512;
  const int lane = tidx() & 63, w = tidx() >> 6, r = lane & 31, h = lane >> 5;
  const float negc = -((const float*)(P.ws + OFF_SC))[1];
  f32x16 O[2][2]; float ls[2];
  const bf16_t* Qp = (const bf16_t*)(P.ws + OFF_QC) + (long)q0 * LDQ + hq * 64;
  const bf16_t* Kp = (const bf16_t*)(P.ws + OFF_KC) + (hq >> 2) * 64;
  const bf16_t* Vp = (const bf16_t*)(P.ws + OFF_VTC) + (long)((hq >> 2) * 64) * VTS;
  if (negc < -64.f) flash_run<2, 2, true>(O, ls, Qp, LDQ, Kp, 128, Vp, negc, smem);
  else flash_run<2, 2, false>(O, ls, Qp, LDQ, Kp, 128, Vp, negc, smem);
  const bf16_t* gate = (const bf16_t*)(P.ws + OFF_GATE);
  bf16_t* mixed = (bf16_t*)(P.ws + OFF_MIXED);
#pragma unroll
  for (int qt = 0; qt < 2; ++qt) {
    const float l = ls[qt] + __shfl_xor(ls[qt], 32);
    const float inv = 1.f / l;
    const int t = q0 + w * 64 + qt * 32 + r;
#pragma unroll
    for (int dt = 0; dt < 2; ++dt) {
      const long off = (long)t * LDH + 1024 + hq * 64 + dt * 32 + 16 * h;
      float g[16], v[16];
      unpack8(*(const uint4*)(gate + off), g); unpack8(*(const uint4*)(gate + off + 8), g + 8);
#pragma unroll
      for (int i = 0; i < 16; ++i) v[i] = O[qt][dt][i] * inv * g[i];
      *(uint4*)(mixed + off) = pack8(v); *(uint4*)(mixed + off + 8) = pack8(v + 8);
    }
  }
}

DI void attn_d_task(const Params& P, int task, char* smem) {
  const int inst = task >> 6, qb = task & 63, q0 = qb * 256, hh = inst >> 1, c = inst & 1;
  const int lane = tidx() & 63, w = tidx() >> 6, r = lane & 31, h = lane >> 5;
  const float negc = -((const float*)(P.ws + OFF_SC))[2];
  f32x16 O[1][4]; float ls[1];
  const bf16_t* Qp = (const bf16_t*)(P.ws + OFF_QD) + (long)q0 * LDQ + inst * 64;
  const bf16_t* Kp = (const bf16_t*)(P.ws + OFF_KD) + inst * 64;
  const bf16_t* Vp = (const bf16_t*)(P.ws + OFF_VTD) + (long)(hh * 128) * VTS;
  if (negc < -64.f) flash_run<1, 4, true>(O, ls, Qp, LDQ, Kp, LDQ, Vp, negc, smem);
  else flash_run<1, 4, false>(O, ls, Qp, LDQ, Kp, LDQ, Vp, negc, smem);
  float* dtmp = (float*)(P.ws + OFF_DTMP) + (long)c * S * 512;
  {
    const float l = ls[0] + __shfl_xor(ls[0], 32);
    const float inv = 1.f / l;
    float* strip = epi_strip(smem);
#pragma unroll
    for (int half = 0; half < 2; ++half) {
      epi_park_o(strip, O[0][2 * half], O[0][2 * half + 1], inv);
#pragma unroll 4
      for (int j = 0; j < 8; ++j) {
        const int row = 4 * j + (lane >> 4), c4 = (lane & 15) * 4;
        const int t = q0 + w * 32 + row;
        *(float4*)(dtmp + (long)t * 512 + hh * 128 + half * 64 + c4) = *(const float4*)(strip + row * EPI_PITCH + c4);
      }
    }
  }
}

template <int DIL, int NSUB>
DI void band_pattern(f32x16 (&O)[2], float& lsum, const bf16x8 (&qf)[4], const bf16_t* Kp  , const bf16_t* Vt  ,
                     int rho, int mstart, int mq, float negc, char* strip) {
  constexpr int ND = S / DIL;
  const int lane = tidx() & 63, r = lane & 31, h = lane >> 5;
  const int krow = lane >> 3, kch = lane & 7, vrow = lane >> 2, vch = lane & 3;
  char* Ks = strip; char* Vs = strip + 32 * 144;
  u32x4 kreg[4], vreg[4];
#define BP_FETCH(SUB) { const int ms_ = mstart + 32 * (SUB); \
    _Pragma("unroll") for (int j = 0; j < 4; ++j) { \
      int m_ = ms_ + krow + 8 * j; m_ = m_ < 0 ? 0 : (m_ > ND - 1 ? ND - 1 : m_); \
      kreg[j] = *(const u32x4*)(Kp + (long)(rho + DIL * m_) * LDQ + kch * 8); } \
    int mc_ = ms_ + vch * 8; mc_ = mc_ < 0 ? 0 : (mc_ > ND - 8 ? ND - 8 : mc_); \
    _Pragma("unroll") for (int j = 0; j < 4; ++j) vreg[j] = *(const u32x4*)(Vt + (long)(vrow + 16 * j) * VTS + rho * ND + mc_); }
  BP_FETCH(0)
  const int koff = kperm(r) * 144 + h * 16, voff = aperm(r) * 80 + h * 16;
  for (int sub = 0; sub < NSUB; ++sub) {
    const int ms = mstart + 32 * sub;
#pragma unroll
    for (int j = 0; j < 4; ++j) *(u32x4*)(Ks + (krow + 8 * j) * 144 + kch * 16) = kreg[j];
#pragma unroll
    for (int j = 0; j < 4; ++j) *(u32x4*)(Vs + (vrow + 16 * j) * 80 + vch * 16) = vreg[j];
    { const int ns = sub + 1 < NSUB ? sub + 1 : NSUB - 1; BP_FETCH(ns) }
    bf16x8 kf[4], vf[2][2];
#pragma unroll
    for (int kk = 0; kk < 4; ++kk) kf[kk] = ld_frag(Ks + koff + kk * 32);
#pragma unroll
    for (int dt = 0; dt < 2; ++dt)
#pragma unroll
      for (int s2 = 0; s2 < 2; ++s2) vf[dt][s2] = ld_frag(Vs + voff + dt * 32 * 80 + s2 * 32);
    f32x16 sx = splat16(negc);
#pragma unroll
    for (int kk = 0; kk < 4; ++kk) sx = mfma(kf[kk], qf[kk], sx);
#pragma unroll
    for (int e = 0; e < 16; ++e) {
      const int me = ms + 16 * (e >> 3) + 8 * h + (e & 7);
      const int dd = me - mq;
      const bool valid = (dd <= 64) && (dd >= -64) && (me >= 0) && (me < ND);
      sx[e] = valid ? __builtin_amdgcn_exp2f(sx[e]) : 0.f;
      lsum += sx[e];
    }
    bf16x8 pf[2];
    pf[0] = packP<0>(sx); pf[1] = packP<1>(sx);
#pragma unroll
    for (int s2 = 0; s2 < 2; ++s2)
#pragma unroll
      for (int dt = 0; dt < 2; ++dt) O[dt] = mfma(vf[dt][s2], pf[s2], O[dt]);
  }
#undef BP_FETCH
}

template <int DIL, int PASS>
DI void attn_a_pass(const Params& P, int wt, char* smem) {
  const int lane = tidx() & 63, r = lane & 31, h = lane >> 5;
  const int head = wt >> 9, rem = wt & 511, rho = rem & (DIL - 1), b = rem / DIL;
  const float negc = -((const float*)(P.ws + OFF_SC))[0];
  const int mq = 32 * b + r, pos = rho + DIL * mq;
  const bf16_t* qa = (const bf16_t*)(P.ws + OFF_QA) + (long)pos * LDQ + head * 64 + 8 * h;
  bf16x8 qf[4];
#pragma unroll
  for (int kk = 0; kk < 4; ++kk) qf[kk] = ld_frag(qa + kk * 16);
  const bf16_t* Kp = (const bf16_t*)(P.ws + OFF_KA) + head * 64;
  const bf16_t* Vt = (const bf16_t*)(P.ws + OFF_VTA) + (long)(DIL == 1 ? 0 : (DIL == 4 ? 512 : 1024)) * VTS + (long)(head * 64) * VTS;
  f32x16 O[2]; O[0] = splat16(0.f); O[1] = splat16(0.f);
  float lsum = 0.f;
  band_pattern<DIL, 5>(O, lsum, qf, Kp, Vt, rho, 32 * b - 64, mq, negc, smem + (tidx() >> 6) * 9728);
  float l = lsum + __shfl_xor(lsum, 32);
  float* ol = (float*)(P.ws + OFF_AOL) + (long)pos * 8 + head;
  if (PASS > 0) l += *ol;
  if (PASS < 2 && h == 0) *ol = l;
  float* strip = (float*)(smem + (tidx() >> 6) * 9728);
  epi_park_o(strip, O[0], O[1], 1.f);
  const bf16_t* gate = (const bf16_t*)(P.ws + OFF_GATE);
  bf16_t* mixed = (bf16_t*)(P.ws + OFF_MIXED);
#pragma unroll 4
  for (int j = 0; j < 8; ++j) {
    const int row = 4 * j + (lane >> 4), c4 = (lane & 15) * 4;
    const int prow = rho + DIL * (32 * b + row);
    float4 a = *(const float4*)(strip + row * EPI_PITCH + c4);
    float* oa = (float*)(P.ws + OFF_AOA) + ((long)prow * 8 + head) * 64 + c4;
    if (PASS > 0) { const float4 pv = *(const float4*)oa; a.x += pv.x; a.y += pv.y; a.z += pv.z; a.w += pv.w; }
    if (PASS < 2) *(float4*)oa = a;
    else {
      const float inv = 1.f / __shfl(l, row);
      const long off = (long)prow * LDH + head * 64 + c4;
      const uint2 gu = *(const uint2*)(gate + off);
      uint2 o;
      o.x = pk2(a.x * inv * __uint_as_float(gu.x << 16), a.y * inv * __uint_as_float(gu.x & 0xffff0000u));
      o.y = pk2(a.z * inv * __uint_as_float(gu.y << 16), a.w * inv * __uint_as_float(gu.y & 0xffff0000u));
      *(uint2*)(mixed + off) = o;
    }
  }
}

DI void s5local_task(const Params& P, int task, char* smem) {
  const int g = task >> 1, mt = task & 1, nt = 0;
  const int lane = tidx() & 63, w = tidx() >> 6, wn = w & 3, wm = w >> 2, r = lane & 31, h = lane >> 5;
  f32x16 acc[2][4]; zero_acc(acc);
  GemmSeg sg{(const bf16_t*)(P.ws + OFF_U) + g * 16, 32 * LDQ, LDQ, (const bf16_t*)(P.ws + OFF_W1) + (long)g * 256 * LDQ, LDQ, 512};
  gemm_kloop(acc, sg, mt * 256, nt * 256, smem);
  float* xl = (float*)(P.ws + OFF_XLOC) + (long)g * 512 * 256;
#pragma unroll
  for (int m4 = 0; m4 < 4; ++m4) {
    const int chunk = mt * 256 + wm * 128 + m4 * 32 + r;
#pragma unroll
    for (int tau = 0; tau < 2; ++tau) {
      float* d = xl + (long)chunk * 256 + nt * 256 + wn * 64 + 32 * h + 16 * tau;
#pragma unroll
      for (int q = 0; q < 4; ++q)
        *(float4*)(d + 4 * q) = make_float4(acc[tau][m4][4 * q], acc[tau][m4][4 * q + 1], acc[tau][m4][4 * q + 2], acc[tau][m4][4 * q + 3]);
    }
  }
}

DI void phase3(const Params& P, char* smem) {
  constexpr int T0 = 512, T1 = T0 + 256, T2 = T1 + 64, T3 = T2 + 512;
  for (int t = blockIdx.x; t < T3; t += gridDim.x) {
    if (t < T0) attn_d_task(P, t, smem);
    else if (t < T1) attn_c_task(P, t - T0, smem);
    else if (t < T2) s5local_task(P, t - T1, smem);
    else attn_a_pass<16, 0>(P, (t - T2) * 8 + (tidx() >> 6), smem);
  }
}

DI void phase4(const Params& P, int li, char* smem) {
  const int lane = tidx() & 63, w = tidx() >> 6;
  const int nw = gridDim.x * 8, gw = blockIdx.x * 8 + w;
  const float* sc = (const float*)(P.ws + OFF_SC);
  const float lam = sc[3], lam_init = sc[4];
  for (int i = blockIdx.x * NT + tidx(); i < 2 * S; i += gridDim.x * NT) ((float*)(P.ws + OFF_RS))[i] = 0.f;
  for (int t = gw; t < 64 + S * 4 + 4096; t += nw) {
    if (t >= 64 + S * 4) {
      attn_a_pass<4, 1>(P, t - (64 + S * 4), smem);
    } else if (t < 64) {
      const int g = t >> 1, dir = t & 1;
      const float2 AT = ((const float2*)(P.ws + OFF_APT))[(dir * 32 + g) * 64 + lane];
      const float* xl = (const float*)(P.ws + OFF_XLOC) + (long)g * 512 * 256 + dir * 128 + lane;
      bf16_t* ci = (bf16_t*)(P.ws + OFF_CIN) + (long)g * 512 * 256 + dir * 128 + lane;
      float xr = 0.f, xi = 0.f;
      for (int s0 = 0; s0 < 512; s0 += 16) {
        float lr[16], lm[16];
#pragma unroll
        for (int u = 0; u < 16; ++u) {
          const int chunk = dir ? 511 - (s0 + u) : s0 + u;
          lr[u] = xl[chunk * 256]; lm[u] = xl[chunk * 256 + 64];
        }
#pragma unroll
        for (int u = 0; u < 16; ++u) {
          const int chunk = dir ? 511 - (s0 + u) : s0 + u;
          ci[chunk * 256] = f2bf(xr); ci[chunk * 256 + 64] = f2bf(xi);
          const float nr = AT.x * xr - AT.y * xi + lr[u], ni = AT.x * xi + AT.y * xr + lm[u];
          xr = nr; xi = ni;
        }
      }
    } else {
      const int tt = (t - 64) >> 2, hh = (t - 64) & 3;
      const long off = (long)tt * 512 + hh * 128 + 2 * lane;
      const float2 o1 = *(const float2*)((const float*)(P.ws + OFF_DTMP) + off);
      const float2 o2 = *(const float2*)((const float*)(P.ws + OFF_DTMP) + (long)S * 512 + off);
      const float a = o1.x - lam * o2.x, b = o1.y - lam * o2.y;
      const float ss = wave_sum(a * a + b * b);
      const float rinv = rsqrtf(ss * (1.f / 128.f) + 1e-6f) * (1.f - lam_init);
      const float2 sw = *(const float2*)(P.d_subln + li * 128 + 2 * lane);
      const long mo = (long)tt * LDH + 1536 + hh * 128 + 2 * lane;
      const unsigned gg = *(const unsigned*)((const bf16_t*)(P.ws + OFF_GATE) + mo);
      const float g0 = __uint_as_float(gg << 16), g1 = __uint_as_float(gg & 0xffff0000u);
      *(unsigned*)((bf16_t*)(P.ws + OFF_MIXED) + mo) = pk2(a * rinv * sw.x * g0, b * rinv * sw.y * g1);
    }
  }
}

DI float gelu_tanh(float y) {
  const float u = 0.7978845608028654f * (y + 0.044715f * y * y * y);
  const float e = __expf(2.f * u);
  const float th = 1.f - 2.f / (e + 1.f);
  return 0.5f * y * (1.f + th);
}

DI void phase5(const Params& P, char* smem) {
  const int lane = tidx() & 63, w = tidx() >> 6, wn = w & 3, wm = w >> 2, r = lane & 31, h = lane >> 5;
  for (int t = blockIdx.x; t < 128 + 512; t += gridDim.x) {
    if (t >= 128) { attn_a_pass<1, 2>(P, (t - 128) * 8 + w, smem); continue; }
    const int g = t >> 2, mt = (t >> 1) & 1, nt = t & 1;
    f32x16 acc[2][4]; zero_acc(acc);
    const bf16_t* W3 = (const bf16_t*)(P.ws + OFF_W3) + (long)g * 512 * 1280;
    const bf16_t* U = (const bf16_t*)(P.ws + OFF_U) + g * 16;
    GemmSeg s0{U, 32 * LDQ, LDQ, W3, 1280, 512};
    gemm_kloop(acc, s0, mt * 256, nt * 256, smem);
    GemmSeg s1{U, 32 * LDQ, LDQ, W3 + 512, 1280, 512};
    gemm_kloop(acc, s1, mt * 256, nt * 256, smem);
    GemmSeg s2{(const bf16_t*)(P.ws + OFF_CIN) + (long)g * 512 * 256, 256, 16, W3 + 1024, 1280, 256};
    gemm_kloop(acc, s2, mt * 256, nt * 256, smem);
    bf16_t* yb = (bf16_t*)(P.ws + OFF_Y);
#pragma unroll
    for (int m4 = 0; m4 < 4; ++m4) {
      const int chunk = mt * 256 + wm * 128 + m4 * 32 + r;
#pragma unroll
      for (int tau = 0; tau < 2; ++tau) {
        const int n = nt * 256 + wn * 64 + 32 * h + 16 * tau;
        const int jo = n >> 4;
        float v[16];
#pragma unroll
        for (int i = 0; i < 16; ++i) v[i] = gelu_tanh(acc[tau][m4][i]);
        bf16_t* d = yb + (long)(chunk * 32 + jo) * LDQ + g * 16;
        *(uint4*)d = pack8(v); *(uint4*)(d + 8) = pack8(v + 8);
      }
    }
  }
}

DI void phase6(const Params& P, int li, char* smem) {
  const int lane = tidx() & 63, w = tidx() >> 6, wn = w & 3, wm = w >> 2, r = lane & 31, h = lane >> 5;
  for (int t = blockIdx.x; t < 64 * 4; t += gridDim.x) {
    const int nt = t >> 6, mt = t & 63;
    f32x16 acc[2][4]; zero_acc(acc);
    GemmSeg sg{(const bf16_t*)(P.ws + OFF_Y), LDQ, 16, (const bf16_t*)(P.ws + OFF_WTGLU), LDQ, 512};
    gemm_kloop(acc, sg, mt * 256, nt * 256, smem);
    const int colb = ((nt * 256 + wn * 64 + 32 * h) >> 5) * 16;
    const float* bg = P.b_glu + li * 1024;
    const bf16_t* gate = (const bf16_t*)(P.ws + OFF_GATE);
    bf16_t* mixed = (bf16_t*)(P.ws + OFF_MIXED);
#pragma unroll
    for (int m4 = 0; m4 < 4; ++m4) {
      const int tok = mt * 256 + wm * 128 + m4 * 32 + r;
      const long off = (long)tok * LDH + 512 + colb;
      float g[16], v[16];
      unpack8(*(const uint4*)(gate + off), g); unpack8(*(const uint4*)(gate + off + 8), g + 8);
#pragma unroll
      for (int i = 0; i < 16; ++i) {
        const float z1 = acc[0][m4][i] + bg[colb + i], z2 = acc[1][m4][i] + bg[512 + colb + i];
        v[i] = z1 * sigmoidf_(z2) * g[i];
      }
      *(uint4*)(mixed + off) = pack8(v); *(uint4*)(mixed + off + 8) = pack8(v + 8);
    }
  }
}

DI void phase7(const Params& P, int li, char* smem) {
  const int lane = tidx() & 63, w = tidx() >> 6, wn = w & 3, wm = w >> 2, r = lane & 31, h = lane >> 5;
  const float* xs = li == 0 ? P.x : P.out;
  for (int t = blockIdx.x; t < 512; t += gridDim.x) {
    const int tt = t & 511, nt = tt >> 6, mt = tt & 63;
    f32x16 acc[2][4]; zero_acc(acc);
    {
      GemmSeg sg{(const bf16_t*)(P.ws + OFF_MIXED), LDH, 16, (const bf16_t*)(P.ws + ((li & 1) ? OFF_WTOUT2 : OFF_WTOUT)), LDH, DM};
      gemm_kloop(acc, sg, mt * 256, nt * 256, smem);
      float* strip = epi_strip(smem);
#pragma unroll
      for (int m4 = 0; m4 < 4; ++m4) {
        epi_park(strip, acc[0][m4], acc[1][m4]);
#pragma unroll 2
        for (int j = 0; j < 8; ++j) {
          const int row = 4 * j + (lane >> 4), c4 = (lane & 15) * 4;
          const int tok = mt * 256 + wm * 128 + m4 * 32 + row;
          const float4 a = *(const float4*)(strip + row * EPI_PITCH + c4);
          const long off = (long)tok * DM + nt * 256 + wn * 64 + c4;
          const float4 xv = *(const float4*)(xs + off);
          const float4 xn = make_float4(xv.x + a.x, xv.y + a.y, xv.z + a.z, xv.w + a.w);
          *(float4*)(P.out + off) = xn;
          uint2 hb2; hb2.x = pk2(xn.x, xn.y); hb2.y = pk2(xn.z, xn.w);
          *(uint2*)((bf16_t*)(P.ws + OFF_H2) + (long)tok * LDH + nt * 256 + wn * 64 + c4) = hb2;
          float ssq = xn.x * xn.x + xn.y * xn.y + xn.z * xn.z + xn.w * xn.w;
          ssq += __shfl_xor(ssq, 1); ssq += __shfl_xor(ssq, 2); ssq += __shfl_xor(ssq, 4); ssq += __shfl_xor(ssq, 8);
          if ((lane & 15) == 0) atomicAdd((float*)(P.ws + OFF_RS) + S + tok, ssq);
        }
      }
    }
  }
}

DI void phase9(const Params& P, int li, char* smem) {
  const int lane = tidx() & 63, w = tidx() >> 6, wn = w & 3, wm = w >> 2, r = lane & 31, h = lane >> 5;
  for (int t = blockIdx.x; t < 512; t += gridDim.x) {
    const int nt = t >> 6, mt = t & 63;
    f32x16 acc[2][4]; zero_acc(acc);
    GemmSeg sg{(const bf16_t*)(P.ws + OFF_H2), LDH, 16, (const bf16_t*)(P.ws + ((li & 1) ? OFF_WTGATE2 : OFF_WTGATE)), LDH, DM};
    gemm_kloop(acc, sg, mt * 256, nt * 256, smem);
    const bf16_t* pe = (const bf16_t*)(P.ws + OFF_PE);
    float* strip = epi_strip(smem);
#pragma unroll
    for (int m4 = 0; m4 < 4; ++m4) {
      epi_park(strip, acc[0][m4], acc[1][m4]);
#pragma unroll 2
      for (int j = 0; j < 8; ++j) {
        const int row = 4 * j + (lane >> 4), c4 = (lane & 15) * 4;
        const int tok = mt * 256 + wm * 128 + m4 * 32 + row;
        const float rin = rsqrtf(((const float*)(P.ws + OFF_RS))[S + tok] * (1.f / DM) + 1e-6f);
        const float4 a = *(const float4*)(strip + row * EPI_PITCH + c4);
        const long off = (long)tok * DM + nt * 256 + wn * 64 + c4;
        const float4 xv = *(const float4*)(P.out + off);
        const uint2 pu = *(const uint2*)(pe + off);
        const float e0 = __uint_as_float(pu.x << 16), e1 = __uint_as_float(pu.x & 0xffff0000u);
        const float e2 = __uint_as_float(pu.y << 16), e3 = __uint_as_float(pu.y & 0xffff0000u);
        const float4 xn = make_float4(xv.x + sigmoidf_(a.x * rin) * e0, xv.y + sigmoidf_(a.y * rin) * e1,
                                      xv.z + sigmoidf_(a.z * rin) * e2, xv.w + sigmoidf_(a.w * rin) * e3);
        *(float4*)(P.out + off) = xn;
        uint2 hb2; hb2.x = pk2(xn.x, xn.y); hb2.y = pk2(xn.z, xn.w);
        *(uint2*)((bf16_t*)(P.ws + OFF_H) + (long)tok * LDH + nt * 256 + wn * 64 + c4) = hb2;
        float ssq = xn.x * xn.x + xn.y * xn.y + xn.z * xn.z + xn.w * xn.w;
        ssq += __shfl_xor(ssq, 1); ssq += __shfl_xor(ssq, 2); ssq += __shfl_xor(ssq, 4); ssq += __shfl_xor(ssq, 8);
        if ((lane & 15) == 0) atomicAdd((float*)(P.ws + OFF_RS) + tok, ssq);
      }
    }
  }
}

#define XB_TMO      128
#define XB_XCNT(j)  (256  + 64 * (j))
#define XB_XSUB(j)  (1280 + 64 * (j))
#define XB_XGEN(j)  (2304 + 64 * (j))
#define XB_TOP      3328
#define XB_TOPGEN   3392
#define XCD_BAR_WORDS 3456
#define XB_SPIN_CAP (1u << 20)
#define LAS __attribute__((address_space(3)))
DI unsigned xb_ld(unsigned* p) { return __hip_atomic_load(p, __ATOMIC_RELAXED, __HIP_MEMORY_SCOPE_AGENT); }
DI unsigned xb_add(unsigned* p, unsigned v) { return __hip_atomic_fetch_add(p, v, __ATOMIC_RELAXED, __HIP_MEMORY_SCOPE_AGENT); }
DI unsigned xb_xcc_id() { return (unsigned)__builtin_amdgcn_s_getreg((3 << 11) | 20) & 0xFu; }
#define XB_SPIN(cond, bar) do { unsigned _sp = 0; while (cond) { __builtin_amdgcn_s_sleep(1); \
    if ((++_sp & 255u) == 0u) { if (xb_ld(&(bar)[XB_TMO])) break; if (_sp > XB_SPIN_CAP) { atomicAdd(&(bar)[XB_TMO], 1u); break; } } } } while (0)
struct XcdBarrier { unsigned* bar; unsigned x; volatile LAS unsigned* st; };
DI XcdBarrier xcd_barrier_post(unsigned* bar, volatile LAS unsigned* st) {
  XcdBarrier b; b.bar = bar; b.x = xb_xcc_id(); b.st = st;
  if (threadIdx.x == 0) (void)xb_add(&bar[XB_XCNT(b.x)], 1u);
  return b;
}
DI void xcd_barrier_complete(unsigned* bar, unsigned x, unsigned& nloc, unsigned& nx) {
  const unsigned G = gridDim.x * gridDim.y * gridDim.z;
  unsigned sum, cnt, mine, sp = 0u;
  for (;;) {
    sum = 0u; cnt = 0u; mine = 0u;
#pragma unroll
    for (unsigned j = 0; j < 16; ++j) { const unsigned c = xb_ld(&bar[XB_XCNT(j)]); sum += c; cnt += (c > 0u) ? 1u : 0u; mine = (j == x) ? c : mine; }
    if (sum == G) break;
    __builtin_amdgcn_s_sleep(1);
    if ((++sp & 255u) == 0u) { if (xb_ld(&bar[XB_TMO])) break; if (sp > XB_SPIN_CAP) { atomicAdd(&bar[XB_TMO], 1u); break; } }
  }
  nloc = mine > 0u ? mine : 1u; nx = cnt > 0u ? cnt : 1u;
}
DI void xcd_barrier(const XcdBarrier& b) {
  asm volatile("s_waitcnt vmcnt(0)" ::: "memory");
  __syncthreads();
  if (threadIdx.x == 0) {
    unsigned* bar = b.bar;
    __builtin_amdgcn_s_waitcnt(0);
    unsigned nloc = b.st[0], nx = b.st[1];
    if (nloc == 0u) { xcd_barrier_complete(bar, b.x, nloc, nx); b.st[0] = nloc; b.st[1] = nx; }
    const unsigned old = xb_add(&bar[XB_XSUB(b.x)], 1u);
    const unsigned gen = old / nloc;
    if (old + 1u == (gen + 1u) * nloc) {
      __builtin_amdgcn_fence(__ATOMIC_RELEASE, "agent");
      asm volatile("s_waitcnt vmcnt(0)" ::: "memory");
      const unsigned og = xb_add(&bar[XB_TOP], 1u);
      const unsigned tg = og / nx;
      if (og + 1u == (tg + 1u) * nx) xb_add(&bar[XB_TOPGEN], 1u);
      else XB_SPIN(xb_ld(&bar[XB_TOPGEN]) == tg, bar);
      __builtin_amdgcn_fence(__ATOMIC_ACQUIRE, "agent");
      xb_add(&bar[XB_XGEN(b.x)], 1u);
      asm volatile("s_waitcnt vmcnt(0)" ::: "memory");
    } else {
      XB_SPIN(xb_ld(&bar[XB_XGEN(b.x)]) == gen, bar);
      __builtin_amdgcn_fence(__ATOMIC_ACQUIRE, "agent");
      asm volatile("s_waitcnt vmcnt(0)" ::: "memory");
    }
  }
  __syncthreads();
}

constexpr int DYN_LDS = 2 * G_STAGE;
__global__ void __launch_bounds__(512, 2) hybrid_fwd(Params P) {
  extern __shared__ __attribute__((aligned(16))) char smem[];
  __shared__ uint4 xb_words;
  if (threadIdx.x == 0) xb_words = make_uint4(0u, 0u, 0u, 0u);
  __syncthreads();
  const XcdBarrier xb = xcd_barrier_post((unsigned*)(P.ws + OFF_BAR), (volatile LAS unsigned*)&xb_words);
  cg::this_grid().sync();
  for (int li = 0; li < NLAYER; ++li) {
    phase1(P, li, smem); xcd_barrier(xb);
    phase2(P, li, smem); xcd_barrier(xb);
    phase3(P, smem); xcd_barrier(xb);
    phase4(P, li, smem); xcd_barrier(xb);
    phase5(P, smem); xcd_barrier(xb);
    phase6(P, li, smem); xcd_barrier(xb);
    phase7(P, li, smem); xcd_barrier(xb);
    phase9(P, li, smem); xcd_barrier(xb);
  }
}

extern "C" void kernel_launch(void* const* d_in, const int* in_sizes, int n_in, void* d_out, int out_size, void* d_ws, size_t ws_size,
                              hipStream_t stream) {
  static int grid_blocks = 0;
  if (!grid_blocks) {
    int dev = 0, cus = 0, per_cu = 0;
    hipGetDevice(&dev);
    hipDeviceGetAttribute(&cus, hipDeviceAttributeMultiprocessorCount, dev);
    hipFuncSetAttribute((const void*)hybrid_fwd, hipFuncAttributeMaxDynamicSharedMemorySize, DYN_LDS);
    hipOccupancyMaxActiveBlocksPerMultiprocessor(&per_cu, hybrid_fwd, NT, DYN_LDS);
    per_cu = 1;
    grid_blocks = cus * per_cu;
  }
  if (ws_size < WS_TOTAL) fprintf(stderr, "workspace too small: %zu < %zu\n", ws_size, (size_t)WS_TOTAL);
  Params P{};
  const float** pp = (const float**)&P;
  for (int i = 0; i < 29; ++i) pp[i] = (const float*)d_in[i];
  P.out = (float*)d_out;
  P.ws = (char*)d_ws;
  hipMemsetAsync((char*)d_ws + OFF_BAR, 0, 4096 * 4, stream);
  void* args[] = {&P};
  hipError_t e = hipLaunchCooperativeKernel((void*)hybrid_fwd, dim3(grid_blocks), dim3(NT), args, DYN_LDS, stream);
  if (e != hipSuccess) fprintf(stderr, "cooperative launch failed: %s (grid %d)\n", hipGetErrorString(e), grid_blocks);
}
```

```cpp
#include <hip/hip_runtime.h>
#include <hip/hip_cooperative_groups.h>
#include <cstdio>
namespace cg = cooperative_groups;

#define DI __device__ __forceinline__
typedef unsigned short bf16_t;
using bf16x8 = __attribute__((ext_vector_type(8))) short;
using f32x16 = __attribute__((ext_vector_type(16))) float;
typedef __attribute__((ext_vector_type(2))) float f32x2_t;
typedef __attribute__((ext_vector_type(4))) unsigned u32x4;
typedef __attribute__((ext_vector_type(2))) __bf16 bf16x2_t;

constexpr int S = 16384;
constexpr int DM = 2048;
constexpr int NC = 6400;
constexpr int NLAYER = 4;
constexpr float LOG2E = 1.4426950408889634f;
constexpr float QSCALE = 0.125f * LOG2E;
constexpr int LDH = DM + 64;
constexpr int LDQ = 512 + 64;
constexpr int VTS = S + 64;

constexpr size_t al(size_t x) { return (x + 255) & ~(size_t)255; }
constexpr size_t OFF_WTIN = 0;
constexpr size_t OFF_WTOUT = OFF_WTIN + al((size_t)NC * LDH * 2);
constexpr size_t OFF_WTGATE = OFF_WTOUT + al((size_t)DM * LDH * 2);
constexpr size_t OFF_WTPLE = OFF_WTGATE + al((size_t)DM * LDH * 2);
constexpr size_t OFF_WTGLU = OFF_WTPLE + al((size_t)DM * 256 * 2);
constexpr size_t OFF_PBF = OFF_WTGLU + al((size_t)1024 * LDQ * 2);
constexpr size_t OFF_W1 = OFF_PBF + al((size_t)S * 256 * 2);
constexpr size_t OFF_W3 = OFF_W1 + al((size_t)32 * 256 * LDQ * 2);
constexpr size_t OFF_APT = OFF_W3 + al((size_t)32 * 512 * 1280 * 2);
constexpr size_t OFF_SC = OFF_APT + al((size_t)2 * 32 * 64 * 8);
constexpr size_t OFF_COS1 = OFF_SC + al(64);
constexpr size_t OFF_SIN1 = OFF_COS1 + al((size_t)S * 8 * 4);
constexpr size_t OFF_AXT = OFF_SIN1 + al((size_t)S * 8 * 4);
constexpr size_t OFF_H = OFF_AXT + al((size_t)(256 + 256 + 64 + 64) * 16 * 4);
constexpr size_t OFF_QA = OFF_H + al((size_t)S * LDH * 2);
constexpr size_t OFF_KA = OFF_QA + al((size_t)S * LDQ * 2);
constexpr size_t OFF_VTA = OFF_KA + al((size_t)S * LDQ * 2);
constexpr size_t OFF_QC = OFF_VTA + al((size_t)3 * 512 * VTS * 2);
constexpr size_t OFF_KC = OFF_QC + al((size_t)S * LDQ * 2);
constexpr size_t OFF_VTC = OFF_KC + al((size_t)S * 128 * 2);
constexpr size_t OFF_QD = OFF_VTC + al((size_t)128 * VTS * 2);
constexpr size_t OFF_KD = OFF_QD + al((size_t)S * LDQ * 2);
constexpr size_t OFF_VTD = OFF_KD + al((size_t)S * LDQ * 2);
constexpr size_t OFF_GATE = OFF_VTD + al((size_t)512 * VTS * 2);
constexpr size_t OFF_U = OFF_GATE + al((size_t)S * LDH * 2);
constexpr size_t OFF_XLOC = OFF_U + al((size_t)S * LDQ * 2);
constexpr size_t OFF_CIN = OFF_XLOC + al((size_t)32 * 512 * 256 * 4);
constexpr size_t OFF_DTMP = OFF_CIN + al((size_t)32 * 512 * 256 * 2);
constexpr size_t OFF_Y = OFF_DTMP + al((size_t)2 * S * 512 * 4);
constexpr size_t OFF_MIXED = OFF_Y + al((size_t)S * LDQ * 2);
constexpr size_t OFF_PE = OFF_MIXED + al((size_t)S * LDH * 2);
constexpr size_t OFF_BAR = OFF_PE + al((size_t)S * DM * 2);
constexpr size_t OFF_H2 = OFF_BAR + al(4096 * 4);
constexpr size_t OFF_RS = OFF_H2 + al((size_t)S * LDH * 2);
constexpr size_t OFF_AOA = OFF_RS + al((size_t)2 * S * 4);
constexpr size_t OFF_AOL = OFF_AOA + al((size_t)S * 512 * 4);
constexpr size_t OFF_WTOUT2 = OFF_AOL + al((size_t)S * 8 * 4);
constexpr size_t OFF_WTGATE2 = OFF_WTOUT2 + al((size_t)DM * LDH * 2);
constexpr size_t WS_TOTAL = OFF_WTGATE2 + al((size_t)DM * LDH * 2);

struct Params {
  const float* x; const float* p; const float* norm_w; const float* w_in; const float* w_out;
  const float* a_q_norm; const float* a_k_norm;
  const float* lam_re; const float* lam_im; const float* log_dt; const float* b_re; const float* b_im;
  const float* c_re; const float* c_im; const float* s5_d; const float* w_glu; const float* b_glu;
  const float* c_q_norm; const float* c_k_norm; const float* d_q_norm; const float* d_k_norm;
  const float* lq1; const float* lk1; const float* lq2; const float* lk2; const float* d_subln;
  const float* ple_norm_w; const float* ple_gate_w; const float* ple_w;
  float* out; char* ws;
};

DI int tidx() { int t = __builtin_amdgcn_workitem_id_x(); asm volatile("" : "+v"(t)); return t; }
DI unsigned pk2(float a, float b) { f32x2_t v = {a, b}; bf16x2_t r = __builtin_convertvector(v, bf16x2_t); return __builtin_bit_cast(unsigned, r); }
DI bf16_t f2bf(float a) { return (bf16_t)(pk2(a, 0.f) & 0xffffu); }
DI float bf2f(bf16_t v) { return __uint_as_float(((unsigned)v) << 16); }
DI float wave_sum(float v) { for (int o = 32; o; o >>= 1) v += __shfl_xor(v, o); return v; }
DI float wave_max(float v) { for (int o = 32; o; o >>= 1) v = fmaxf(v, __shfl_xor(v, o)); return v; }
DI f32x16 mfma(bf16x8 a, bf16x8 b, f32x16 c) { return __builtin_amdgcn_mfma_f32_32x32x16_bf16(a, b, c, 0, 0, 0); }
DI f32x16 splat16(float v) { f32x16 r; for (int i = 0; i < 16; ++i) r[i] = v; return r; }
DI uint4 pack8(const float* f) { uint4 u; u.x = pk2(f[0], f[1]); u.y = pk2(f[2], f[3]); u.z = pk2(f[4], f[5]); u.w = pk2(f[6], f[7]); return u; }
DI void unpack8(uint4 u, float* f) {
  f[0] = __uint_as_float(u.x << 16); f[1] = __uint_as_float(u.x & 0xffff0000u);
  f[2] = __uint_as_float(u.y << 16); f[3] = __uint_as_float(u.y & 0xffff0000u);
  f[4] = __uint_as_float(u.z << 16); f[5] = __uint_as_float(u.z & 0xffff0000u);
  f[6] = __uint_as_float(u.w << 16); f[7] = __uint_as_float(u.w & 0xffff0000u);
}
DI bf16x8 ld_frag(const void* p) { return *(const bf16x8*)p; }
template <int S_>
DI bf16x8 packP(const f32x16& p) {
  uint4 u; u.x = pk2(p[8 * S_], p[8 * S_ + 1]); u.y = pk2(p[8 * S_ + 2], p[8 * S_ + 3]); u.z = pk2(p[8 * S_ + 4], p[8 * S_ + 5]); u.w = pk2(p[8 * S_ + 6], p[8 * S_ + 7]);
  return __builtin_bit_cast(bf16x8, u);
}
DI float sigmoidf_(float x) { return 1.f / (1.f + __expf(-x)); }
DI float siluf_(float x) { return x / (1.f + __expf(-x)); }
DI int aperm(int r) { return 16 * ((r >> 2) & 1) + (r & 3) + 4 * (r >> 3); }
DI int kperm(int r) { return (r & 16) | (((r >> 2) & 1) << 3) | (((r >> 3) & 1) << 2) | (r & 3); }

constexpr int NT = 512;
constexpr int G_STAGE = 512 * 128;
struct GemmSeg { const bf16_t* A; long lda; int ks16; const bf16_t* B; long ldb; int K; };

DI void gemm_kloop(f32x16 (&acc)[2][4], const GemmSeg sg, int m0, int n0, char* smem) {
  const int tid = tidx(), lane = tid & 63, w = tid >> 6, wn = w & 3, wm = w >> 2;
  const int r = lane & 31, h = lane >> 5;
  const int srow = tid >> 3, kc = tid & 7;
  const bf16_t* bsrc = sg.B + (long)(n0 + srow) * sg.ldb + kc * 8;
  const bf16_t* asrc = sg.A + (long)(m0 + srow) * sg.lda + (long)(kc >> 1) * sg.ks16 + (kc & 1) * 8;
  const long bstep = 64 * sg.ldb, astep = 64 * sg.lda;
  const int lo = srow * 128 + ((kc ^ ((srow >> 1) & 7)) * 16);
  const int nk = sg.K >> 6;
  u32x4 st[8];
#define G_LOAD(KT) { const int k0_ = (KT) << 6; const long ka_ = (long)(k0_ >> 4) * sg.ks16; \
    st[0] = *(const u32x4*)(bsrc + k0_); st[1] = *(const u32x4*)(bsrc + bstep + k0_); \
    st[2] = *(const u32x4*)(bsrc + 2 * bstep + k0_); st[3] = *(const u32x4*)(bsrc + 3 * bstep + k0_); \
    st[4] = *(const u32x4*)(asrc + ka_); st[5] = *(const u32x4*)(asrc + astep + ka_); \
    st[6] = *(const u32x4*)(asrc + 2 * astep + ka_); st[7] = *(const u32x4*)(asrc + 3 * astep + ka_); }
#define G_WRITE(BUF) { char* d_ = smem + (BUF) * G_STAGE + lo; \
    *(u32x4*)(d_) = st[0]; *(u32x4*)(d_ + 64 * 128) = st[1]; *(u32x4*)(d_ + 128 * 128) = st[2]; *(u32x4*)(d_ + 192 * 128) = st[3]; \
    *(u32x4*)(d_ + 256 * 128) = st[4]; *(u32x4*)(d_ + 320 * 128) = st[5]; *(u32x4*)(d_ + 384 * 128) = st[6]; *(u32x4*)(d_ + 448 * 128) = st[7]; }
  const int woff = (wn * 64 + aperm(r) + 16 * ((r >> 2) & 1)) * 128;
  const int aoff = (256 + wm * 128 + r) * 128;
  const int wsw = ((r >> 1) & 1) + 2 * (r >> 3);
  const int asw = (r >> 1) & 7;
  G_LOAD(0)
  __syncthreads();
  G_WRITE(0)
  G_LOAD(1)
  __syncthreads();
#define G_PART(P_, KT, BUF) { const int k0_ = (KT) << 6; const long ka_ = (long)(k0_ >> 4) * sg.ks16; char* d_ = smem + (BUF) * G_STAGE + lo; \
    *(u32x4*)(d_ + (P_) * 64 * 128) = st[P_]; *(u32x4*)(d_ + (256 + (P_) * 64) * 128) = st[4 + (P_)]; \
    st[P_] = *(const u32x4*)(bsrc + (P_) * bstep + k0_); st[4 + (P_)] = *(const u32x4*)(asrc + (P_) * astep + ka_); }
  for (int kt = 0; kt < nk; ++kt) {
    const int kn = kt + 2 < nk ? kt + 2 : nk - 1;
    const char* sb = smem + (kt & 1) * G_STAGE;
#pragma unroll
    for (int ks = 0; ks < 4; ++ks) {
      bf16x8 wf[2], af[4];
#pragma unroll
      for (int tau = 0; tau < 2; ++tau) wf[tau] = ld_frag(sb + woff + tau * 16 * 128 + (((ks * 2 + h) ^ wsw) * 16));
#pragma unroll
      for (int mt = 0; mt < 4; ++mt) af[mt] = ld_frag(sb + aoff + mt * 32 * 128 + (((ks * 2 + h) ^ asw) * 16));
#pragma unroll
      for (int tau = 0; tau < 2; ++tau)
#pragma unroll
        for (int mt = 0; mt < 4; ++mt) acc[tau][mt] = mfma(wf[tau], af[mt], acc[tau][mt]);
      if (ks == 0) G_PART(0, kn, (kt + 1) & 1)
      if (ks == 1) G_PART(1, kn, (kt + 1) & 1)
      if (ks == 2) G_PART(2, kn, (kt + 1) & 1)
      if (ks == 3) G_PART(3, kn, (kt + 1) & 1)
    }
    __syncthreads();
  }
#undef G_PART
#undef G_LOAD
#undef G_WRITE
}

DI void zero_acc(f32x16 (&acc)[2][4]) {
#pragma unroll
  for (int a = 0; a < 2; ++a)
#pragma unroll
    for (int b = 0; b < 4; ++b) acc[a][b] = splat16(0.f);
}

DI void transpose_task(const float* src, int N, int ldd, bf16_t* dst, int tile, int ntn, bool glu, char* smem, const float* kscale = nullptr) {
  float* tl = (float*)smem;
  const int tid = tidx();
  const int kt = tile / ntn, nt = tile - kt * ntn, k0 = kt * 64, n0 = nt * 64;
  __syncthreads();
#pragma unroll
  for (int j = 0; j < 2; ++j) {
    const int k = (tid >> 4) + 32 * j, n4 = (tid & 15) * 4;
    const float4 v = *(const float4*)(src + (long)(k0 + k) * N + n0 + n4);
    const float sc = kscale ? kscale[k0 + k] : 1.f;
    tl[k * 65 + n4] = v.x * sc; tl[k * 65 + n4 + 1] = v.y * sc; tl[k * 65 + n4 + 2] = v.z * sc; tl[k * 65 + n4 + 3] = v.w * sc;
  }
  __syncthreads();
  {
    const int n = tid >> 3, k8 = (tid & 7) * 8;
    float f[8];
#pragma unroll
    for (int e = 0; e < 8; ++e) f[e] = tl[(k8 + e) * 65 + n];
    const int nsrc = n0 + n;
    const int ndst = glu ? (32 * ((nsrc & 511) >> 4) + 16 * (nsrc >> 9) + (nsrc & 15)) : nsrc;
    *(uint4*)(dst + (long)ndst * ldd + k0 + k8) = pack8(f);
  }
}

DI void sincos_rev(double ang, float& cs, float& sn) {
  const double rev = ang * 0.15915494309189535;
  const float fr = (float)(rev - rint(rev));
  cs = __builtin_amdgcn_cosf(fr); sn = __builtin_amdgcn_sinf(fr);
}
__constant__ double ROPE1_INV[8] = {1.0, 0.19392274474868576, 0.03760603093086393, 0.007292664737217109, 0.001414213562373095, 0.0002742481756762073, 5.318295896944988e-05, 1.031338537721246e-05};
__constant__ double AXIAL_INV[16] = {1.0, 0.5623413251903491, 0.31622776601683794, 0.1778279410038923, 0.1, 0.05623413251903491, 0.03162277660168379, 0.01778279410038923,
                                     0.01, 0.005623413251903491, 0.0031622776601683794, 0.001778279410038923, 0.001, 0.0005623413251903491, 0.00031622776601683794, 0.0001778279410038923};

DI void s5prep_task(const Params& P, int li, int g, int dir, int q, char* smem) {
  float2* Apow = (float2*)smem;
  float2* Bbar = Apow + 33 * 64;
  float2* Cc = Bbar + 64 * 16;
  float* Kt = (float*)(Cc + 16 * 64);
  const int tid = tidx();
  const long gp = (((long)li * 2 + dir) * 32 + g) * 64;
  const float dtf = expf(P.log_dt[(li * 2 + dir) * 32 + g]);
  const double dt = (double)dtf;
  bf16_t* W1 = (bf16_t*)(P.ws + OFF_W1) + (long)g * 256 * LDQ;
  bf16_t* W3 = (bf16_t*)(P.ws + OFF_W3) + (long)g * 512 * 1280;
  float2* apT = (float2*)(P.ws + OFF_APT);
  const float* cre = P.c_re + (((long)li * 2 + dir) * 32 + g) * 16 * 64;
  const float* cim = P.c_im + (((long)li * 2 + dir) * 32 + g) * 16 * 64;
  __syncthreads();
  for (int idx = tid; idx < 33 * 64; idx += NT) {
    const int e = idx >> 6, p = idx & 63;
    const double lr = P.lam_re[gp + p], lim = P.lam_im[gp + p];
    const float mag = expf((float)((double)e * lr * dt));
    float cs, sn; sincos_rev((double)e * lim * dt, cs, sn);
    Apow[idx] = make_float2(mag * cs, mag * sn);
  }
  for (int idx = tid; idx < 64 * 16; idx += NT) {
    const int p = idx >> 4, c = idx & 15;
    const double lr = P.lam_re[gp + p], lim = P.lam_im[gp + p];
    float cs, sn; sincos_rev(lim * dt, cs, sn);
    const double mag = (double)expf((float)(lr * dt)), ar = mag * cs, ai = mag * sn;
    const double den = lr * lr + lim * lim;
    const double cr = ((ar - 1.0) * lr + ai * lim) / den, ci = (ai * lr - (ar - 1.0) * lim) / den;
    const double br = P.b_re[(gp + p) * 16 + c], bi = P.b_im[(gp + p) * 16 + c];
    Bbar[idx] = make_float2((float)(cr * br - ci * bi), (float)(cr * bi + ci * br));
    Cc[idx] = make_float2(cre[idx], cim[idx]);
  }
  __syncthreads();
  if (q == 0 && tid < 64) apT[(dir * 32 + g) * 64 + tid] = Apow[32 * 64 + tid];
  for (int idx = tid; idx < 2048; idx += NT) {
    const int dl = 8 * q + (idx >> 8), co = (idx >> 4) & 15, ci = idx & 15;
    float a = 0.f;
    for (int p = 0; p < 64; ++p) {
      const float2 ap = Apow[dl * 64 + p];
      const float2 cc = Cc[co * 64 + p];
      const float gr = cc.x * ap.x - cc.y * ap.y, gi = cc.x * ap.y + cc.y * ap.x;
      const float2 b = Bbar[p * 16 + ci];
      a += gr * b.x - gi * b.y;
    }
    Kt[idx] = a;
  }
  __syncthreads();
  for (int ch = tid; ch < 128 * 16; ch += NT) {
    const int row = ch >> 4, kc = 16 * q + (ch & 15), part = row >> 6, p = row & 63, j = kc >> 1, c0 = (kc & 1) * 8;
    const int e = dir == 0 ? 31 - j : j;
    const float2 a = Apow[e * 64 + p];
    float f[8];
#pragma unroll
    for (int u = 0; u < 8; ++u) {
      const float2 b = Bbar[p * 16 + c0 + u];
      f[u] = part == 0 ? (a.x * b.x - a.y * b.y) : (a.x * b.y + a.y * b.x);
    }
    *(uint4*)(W1 + (long)(dir * 128 + row) * LDQ + kc * 8) = pack8(f);
  }
  for (int ch = tid; ch < 512 * 64; ch += NT) {
    const int n = ch >> 6, kc = ch & 63, jo = n >> 4, co = n & 15, ji = kc >> 1, ci0 = (kc & 1) * 8;
    const int dl = dir == 0 ? jo - ji : ji - jo;
    const bool mine = dl < 0 ? (q == 0) : ((dl >> 3) == q);
    if (mine) {
      float f[8];
#pragma unroll
      for (int u = 0; u < 8; ++u) {
        float v = 0.f;
        if (dl >= 0) {
          v = Kt[(dl & 7) * 256 + co * 16 + ci0 + u];
          if (dir == 0 && dl == 0 && co == ci0 + u) v += P.s5_d[li * 512 + g * 16 + co];
        }
        f[u] = v;
      }
      *(uint4*)(W3 + (long)n * 1280 + dir * 512 + kc * 8) = pack8(f);
    }
  }
  for (int ch = tid; ch < 128 * 16; ch += NT) {
    const int n = 128 * q + (ch >> 4), pc = ch & 15, part = pc >> 3, p0 = (pc & 7) * 8, jo = n >> 4, co = n & 15;
    const int e = dir == 0 ? jo + 1 : 32 - jo;
    float f[8];
#pragma unroll
    for (int u = 0; u < 8; ++u) {
      const int p = p0 + u;
      const float2 a = Apow[e * 64 + p];
      const float2 cc = Cc[co * 64 + p];
      const float gr = cc.x * a.x - cc.y * a.y, gi = cc.x * a.y + cc.y * a.x;
      f[u] = part == 0 ? gr : -gi;
    }
    *(uint4*)(W3 + (long)n * 1280 + 1024 + dir * 128 + part * 64 + p0) = pack8(f);
  }
}

DI void cvt_rows(const float* xs, bf16_t* hb, float* rs, int row0) {
  const int lane = tidx() & 63, w = tidx() >> 6;
  const int row = row0 + w;
  const float4* xr = (const float4*)(xs + (long)row * DM);
  float ss = 0.f;
#pragma unroll
  for (int j = 0; j < 8; ++j) {
    const float4 v = xr[lane + 64 * j];
    ss += v.x * v.x + v.y * v.y + v.z * v.z + v.w * v.w;
    uint2 o; o.x = pk2(v.x, v.y); o.y = pk2(v.z, v.w);
    *(uint2*)(hb + (long)row * LDH + (lane + 64 * j) * 4) = o;
  }
  ss = wave_sum(ss);
  if (lane == 0) rs[row] = ss;
}

DI void phase1(const Params& P, int li, char* smem) {
  const int tid = tidx();
  bf16_t* hb = (bf16_t*)(P.ws + OFF_H);
  constexpr int T0 = 256, T1 = T0 + 3200, T2 = T1 + 1024, T3 = T2 + 1024, T4 = T3 + 128, T5 = T4 + 128;
  constexpr int T6 = T5 + 2048, T7 = T6 + 1024, T8 = T7 + 1, T9 = T8 + 64;
  const int ntask = li == 0 ? T9 : T8;
  for (int t = blockIdx.x; t < ntask; t += gridDim.x) {
    if (t < T0) s5prep_task(P, li, t >> 3, (t >> 2) & 1, t & 3, smem);
    else if (t < T1) transpose_task(P.w_in + (long)li * DM * NC, NC, LDH, (bf16_t*)(P.ws + OFF_WTIN), t - T0, 100, false, smem, P.norm_w + li * DM);
    else if (t < T2) { if (li == 0) transpose_task(P.w_out, DM, LDH, (bf16_t*)(P.ws + OFF_WTOUT), t - T1, 32, false, smem); }
    else if (t < T3) { if (li == 0) transpose_task(P.ple_gate_w, DM, LDH, (bf16_t*)(P.ws + OFF_WTGATE), t - T2, 32, false, smem, P.ple_norm_w); }
    else if (t < T4) transpose_task(P.ple_w + (long)li * 256 * DM, DM, 256, (bf16_t*)(P.ws + OFF_WTPLE), t - T3, 32, false, smem);
    else if (t < T5) transpose_task(P.w_glu + (long)li * 512 * 1024, 1024, LDQ, (bf16_t*)(P.ws + OFF_WTGLU), t - T4, 16, true, smem);
    else if (t < T6) { if (li == 0) cvt_rows(P.x, hb, (float*)(P.ws + OFF_RS), (t - T5) * 8); }
    else if (t < T7) {
      const float4* ps = (const float4*)(P.p + (long)li * S * 256) + (long)(t - T6) * 1024;
      uint2* pd = (uint2*)(P.ws + OFF_PBF) + (long)(t - T6) * 1024;
#pragma unroll
      for (int j = 0; j < 2; ++j) { const float4 v = ps[tid + NT * j]; uint2 o; o.x = pk2(v.x, v.y); o.y = pk2(v.z, v.w); pd[tid + NT * j] = o; }
    } else if (t < T8) {
      if (tid < 64) {
        float* sc = (float*)(P.ws + OFF_SC);
        const float mqa = wave_max(fabsf(P.a_q_norm[li * 64 + tid])), mka = wave_max(fabsf(P.a_k_norm[li * 64 + tid]));
        const float mqc = wave_max(fabsf(P.c_q_norm[li * 64 + tid])), mkc = wave_max(fabsf(P.c_k_norm[li * 64 + tid]));
        const float mqd = wave_max(fabsf(P.d_q_norm[li * 64 + tid])), mkd = wave_max(fabsf(P.d_k_norm[li * 64 + tid]));
        const float s1 = wave_sum(P.lq1[li * 64 + tid] * P.lk1[li * 64 + tid]);
        const float s2 = wave_sum(P.lq2[li * 64 + tid] * P.lk2[li * 64 + tid]);
        if (tid == 0) {
          sc[0] = 8.f * LOG2E * mqa * mka; sc[1] = 8.f * LOG2E * mqc * mkc; sc[2] = 8.f * LOG2E * mqd * mkd;
          const float lam_init = 0.8f - 0.6f * expf(-0.3f * (float)li);
          sc[3] = expf(s1) - expf(s2) + lam_init; sc[4] = lam_init;
        }
      }
    } else {
      float* c1 = (float*)(P.ws + OFF_COS1); float* s1 = (float*)(P.ws + OFF_SIN1);
      float* ax = (float*)(P.ws + OFF_AXT);
      const int b = t - T8;
      for (int idx = b * 2048 + tid; idx < (b + 1) * 2048; idx += NT) {
        const int tt = idx >> 3, i = idx & 7;
        float cs, sn; sincos_rev((double)tt * ROPE1_INV[i], cs, sn);
        c1[idx] = cs; s1[idx] = sn;
      }
      if (b == 0) {
        for (int idx = tid; idx < 256 * 16; idx += NT) {
          float cs, sn; sincos_rev((double)((idx >> 4) - 128) * AXIAL_INV[idx & 15], cs, sn);
          ax[idx] = cs; ax[4096 + idx] = sn;
        }
        for (int idx = tid; idx < 64 * 16; idx += NT) {
          float cs, sn; sincos_rev((double)((idx >> 4) - 32) * AXIAL_INV[idx & 15], cs, sn);
          ax[8192 + idx] = cs; ax[8192 + 1024 + idx] = sn;
        }
      }
    }
  }
}

DI void rows_bf16_store(char* smem, const float* v, bf16_t* dst0, long ld) {
  const int lane = tidx() & 63, r = lane & 31, h = lane >> 5;
  char* strip = smem + (tidx() >> 6) * (32 * 144);
#pragma unroll
  for (int q = 0; q < 4; ++q) *(uint4*)(strip + r * 144 + h * 64 + q * 16) = pack8(v + 8 * q);
#pragma unroll
  for (int j = 0; j < 4; ++j) {
    const int row = (lane >> 3) + 8 * j, ch = lane & 7;
    *(uint4*)(dst0 + (long)row * ld + ch * 8) = *(const uint4*)(strip + row * 144 + ch * 16);
  }
}

DI void rows_bf16_store_acc(char* smem, const f32x16& a0, const f32x16& a1, bf16_t* dst0, long ld) {
  const int lane = tidx() & 63, r = lane & 31, h = lane >> 5;
  char* strip = smem + (tidx() >> 6) * (32 * 144);
  *(bf16x8*)(strip + r * 144 + h * 64) = packP<0>(a0); *(bf16x8*)(strip + r * 144 + h * 64 + 16) = packP<1>(a0);
  *(bf16x8*)(strip + r * 144 + h * 64 + 32) = packP<0>(a1); *(bf16x8*)(strip + r * 144 + h * 64 + 48) = packP<1>(a1);
#pragma unroll
  for (int j = 0; j < 4; ++j) {
    const int row = (lane >> 3) + 8 * j, ch = lane & 7;
    *(uint4*)(dst0 + (long)row * ld + ch * 8) = *(const uint4*)(strip + row * 144 + ch * 16);
  }
}

template <int DIL>
DI void vt_store(char* smem, const f32x16 (&acc)[2][4], const float (&rin)[4], bf16_t* img  , int tbase) {
  const int lane = tidx() & 63, r = lane & 31, h = lane >> 5;
  bf16_t* strip = (bf16_t*)(smem + (tidx() >> 6) * 16384);
#pragma unroll
  for (int mt = 0; mt < 4; ++mt) {
    const int tl = mt * 32 + r, pp = (tl % DIL) * (128 / DIL) + tl / DIL;
#pragma unroll
    for (int tau = 0; tau < 2; ++tau)
#pragma unroll
      for (int i = 0; i < 16; ++i) strip[(32 * h + 16 * tau + i) * 128 + pp] = f2bf(acc[tau][mt][i] * rin[mt]);
  }
#pragma unroll 4
  for (int j = 0; j < 16; ++j) {
    const int c = lane + 64 * j, row = c >> 4, p0 = (c & 15) * 8;
    const int rho = p0 / (128 / DIL), o = p0 % (128 / DIL);
    *(uint4*)(img + (long)row * VTS + (long)rho * (S / DIL) + tbase / DIL + o) = *(const uint4*)(strip + row * 128 + p0);
  }
}

DI void inproj_epilogue(const Params& P, int li, f32x16 (&acc)[2][4], int mbase, int nbase, char* smem) {
  const int lane = tidx() & 63, r = lane & 31, h = lane >> 5;
  char* ws = P.ws;
  int kind; bf16_t* dst = nullptr; int ld = 0, col = 0; const float* nw = nullptr; float qs = 1.f;
  if (nbase < 512) { kind = 0; dst = (bf16_t*)(ws + OFF_QA); ld = LDQ; col = nbase; nw = P.a_q_norm + li * 64; qs = QSCALE; }
  else if (nbase < 1024) { kind = 0; dst = (bf16_t*)(ws + OFF_KA); ld = LDQ; col = nbase - 512; nw = P.a_k_norm + li * 64; }
  else if (nbase < 1536) { kind = 3; dst = (bf16_t*)(ws + OFF_VTA); col = nbase - 1024; }
  else if (nbase < 2048) { kind = 4; col = nbase - 1536; }
  else if (nbase < 2560) { kind = 5; col = nbase - 2048; }
  else if (nbase < 3072) { kind = 4; col = 512 + nbase - 2560; }
  else if (nbase < 3584) { kind = 1; dst = (bf16_t*)(ws + OFF_QC); ld = LDQ; col = nbase - 3072; nw = P.c_q_norm + li * 64; qs = QSCALE; }
  else if (nbase < 3712) { kind = 1; dst = (bf16_t*)(ws + OFF_KC); ld = 128; col = nbase - 3584; nw = P.c_k_norm + li * 64; }
  else if (nbase < 3840) { kind = 2; dst = (bf16_t*)(ws + OFF_VTC); col = nbase - 3712; }
  else if (nbase < 4352) { kind = 4; col = 1024 + nbase - 3840; }
  else if (nbase < 4864) { kind = 0; dst = (bf16_t*)(ws + OFF_QD); ld = LDQ; col = nbase - 4352; nw = P.d_q_norm + li * 64; qs = QSCALE; }
  else if (nbase < 5376) { kind = 0; dst = (bf16_t*)(ws + OFF_KD); ld = LDQ; col = nbase - 4864; nw = P.d_k_norm + li * 64; }
  else if (nbase < 5888) { kind = 2; dst = (bf16_t*)(ws + OFF_VTD); col = nbase - 5376; }
  else { kind = 4; col = 1536 + nbase - 5888; }

  if (kind == 2 || kind == 3) {
    float rinv4[4];
#pragma unroll
    for (int mt = 0; mt < 4; ++mt) rinv4[mt] = rsqrtf(((const float*)(ws + OFF_RS))[mbase + mt * 32 + r] * (1.f / DM) + 1e-6f);
    vt_store<1>(smem, acc, rinv4, dst + (long)col * VTS, mbase);
    if (kind == 3) {
      vt_store<4>(smem, acc, rinv4, dst + (long)(512 + col) * VTS, mbase);
      vt_store<16>(smem, acc, rinv4, dst + (long)(1024 + col) * VTS, mbase);
    }
    return;
  }
#pragma unroll
  for (int mt = 0; mt < 4; ++mt) {
    const int t = mbase + mt * 32 + r;
    float v[32];
    const float rin = rsqrtf(((const float*)(ws + OFF_RS))[t] * (1.f / DM) + 1e-6f);
#pragma unroll
    for (int i = 0; i < 16; ++i) { v[i] = acc[0][mt][i] * rin; v[16 + i] = acc[1][mt][i] * rin; }
    if (kind <= 1) {
      float ss = 0.f;
#pragma unroll
      for (int i = 0; i < 32; ++i) ss += v[i] * v[i];
      ss += __shfl_xor(ss, 32);
      const float rinv = rsqrtf(ss * (1.f / 64.f) + 1e-6f);
#pragma unroll
      for (int i = 0; i < 32; ++i) v[i] *= rinv * nw[32 * h + i];
      if (kind == 0) {
        if (h == 0) {
          const float* cs = (const float*)(ws + OFF_COS1) + (long)t * 8;
          const float* sn = (const float*)(ws + OFF_SIN1) + (long)t * 8;
#pragma unroll
          for (int i = 0; i < 8; ++i) {
            const float c = cs[i], s = sn[i], x1 = v[i], x2 = v[i + 8];
            v[i] = x1 * c - x2 * s; v[i + 8] = x1 * s + x2 * c;
          }
        }
      } else {
        const float* ax = (const float*)(ws + OFF_AXT);
        const float* cs = h == 0 ? ax + (t >> 6) * 16 : ax + 8192 + (t & 63) * 16;
        const float* sn = h == 0 ? ax + 4096 + (t >> 6) * 16 : ax + 8192 + 1024 + (t & 63) * 16;
#pragma unroll
        for (int i = 0; i < 16; ++i) {
          const float c = cs[i], s = sn[i], x1 = v[i], x2 = v[i + 16];
          v[i] = x1 * c - x2 * s; v[i + 16] = x1 * s + x2 * c;
        }
      }
#pragma unroll
      for (int i = 0; i < 32; ++i) v[i] *= qs;
      rows_bf16_store(smem, v, dst + (long)(mbase + mt * 32) * ld + col, ld);
    } else if (kind == 4) {
#pragma unroll
      for (int i = 0; i < 32; ++i) v[i] = siluf_(v[i]);
      rows_bf16_store(smem, v, (bf16_t*)(ws + OFF_GATE) + (long)(mbase + mt * 32) * LDH + col, LDH);
    } else {
      rows_bf16_store(smem, v, (bf16_t*)(ws + OFF_U) + (long)(mbase + mt * 32) * LDQ + col, LDQ);
    }
  }
}

DI void pe_tile(const Params& P, int tt, char* smem) {
  const int lane = tidx() & 63, w = tidx() >> 6, wn = w & 3, wm = w >> 2, r = lane & 31, h = lane >> 5;
  const int nt = tt >> 6, mt = tt & 63;
  f32x16 acc[2][4]; zero_acc(acc);
  GemmSeg sg{(const bf16_t*)(P.ws + OFF_PBF), 256, 16, (const bf16_t*)(P.ws + OFF_WTPLE), 256, 256};
  gemm_kloop(acc, sg, mt * 256, nt * 256, smem);
  bf16_t* pe = (bf16_t*)(P.ws + OFF_PE);
#pragma unroll
  for (int m4 = 0; m4 < 4; ++m4) {
    char* strip = smem + w * (32 * 144);
    *(bf16x8*)(strip + r * 144 + h * 64) = packP<0>(acc[0][m4]); *(bf16x8*)(strip + r * 144 + h * 64 + 16) = packP<1>(acc[0][m4]);
    *(bf16x8*)(strip + r * 144 + h * 64 + 32) = packP<0>(acc[1][m4]); *(bf16x8*)(strip + r * 144 + h * 64 + 48) = packP<1>(acc[1][m4]);
    bf16_t* dst0 = pe + (long)(mt * 256 + wm * 128 + m4 * 32) * DM + nt * 256 + wn * 64;
#pragma unroll
    for (int j = 0; j < 4; ++j) {
      const int row = (lane >> 3) + 8 * j, ch = lane & 7;
      *(uint4*)(dst0 + (long)row * DM + ch * 8) = *(const uint4*)(strip + row * 144 + ch * 16);
    }
  }
}

DI void phase2(const Params& P, int li, char* smem) {
  const int w = tidx() >> 6, wn = w & 3, wm = w >> 2;
  for (int t = blockIdx.x; t < 64 * 25; t += gridDim.x) {
    const int nt = t >> 6, mt = t & 63;
    f32x16 acc[2][4]; zero_acc(acc);
    GemmSeg sg{(const bf16_t*)(P.ws + OFF_H), LDH, 16, (const bf16_t*)(P.ws + OFF_WTIN), LDH, DM};
    gemm_kloop(acc, sg, mt * 256, nt * 256, smem);
    inproj_epilogue(P, li, acc, mt * 256 + wm * 128, nt * 256 + wn * 64, smem);
  }
  const int b0 = gridDim.x == 256 ? 64 : 0, nb = gridDim.x - b0;
  if ((int)blockIdx.x >= b0) {
    for (int pt = blockIdx.x - b0; pt < 512; pt += nb) pe_tile(P, pt, smem);
    if (li + 1 < NLAYER) {
      const int ln = li + 1;
      bf16_t* wo = (bf16_t*)(P.ws + ((ln & 1) ? OFF_WTOUT2 : OFF_WTOUT));
      bf16_t* wg = (bf16_t*)(P.ws + ((ln & 1) ? OFF_WTGATE2 : OFF_WTGATE));
      for (int tt = blockIdx.x - b0; tt < 2048; tt += nb) {
        if (tt < 1024) transpose_task(P.w_out + (long)ln * DM * DM, DM, LDH, wo, tt, 32, false, smem);
        else transpose_task(P.ple_gate_w + (long)ln * DM * DM, DM, LDH, wg, tt - 1024, 32, false, smem, P.ple_norm_w + ln * DM);
      }
    }
  }
}


constexpr int EPI_PITCH = 68;
DI float* epi_strip(char* smem) { return (float*)smem + (tidx() >> 6) * (32 * EPI_PITCH); }
DI void epi_park(float* strip, const f32x16& a0, const f32x16& a1) {
  const int lane = tidx() & 63, r = lane & 31, h = lane >> 5;
  float* d = strip + r * EPI_PITCH + 32 * h;
#pragma unroll
  for (int q = 0; q < 4; ++q) {
    *(float4*)(d + 4 * q) = make_float4(a0[4 * q], a0[4 * q + 1], a0[4 * q + 2], a0[4 * q + 3]);
    *(float4*)(d + 16 + 4 * q) = make_float4(a1[4 * q], a1[4 * q + 1], a1[4 * q + 2], a1[4 * q + 3]);
  }
}

DI void epi_park_o(float* strip, const f32x16& o0, const f32x16& o1, float sc) {
  const int lane = tidx() & 63, r = lane & 31, h = lane >> 5;
  float* d = strip + r * EPI_PITCH + 16 * h;
#pragma unroll
  for (int q = 0; q < 4; ++q) {
    *(float4*)(d + 4 * q) = make_float4(o0[4 * q] * sc, o0[4 * q + 1] * sc, o0[4 * q + 2] * sc, o0[4 * q + 3] * sc);
    *(float4*)(d + 32 + 4 * q) = make_float4(o1[4 * q] * sc, o1[4 * q + 1] * sc, o1[4 * q + 2] * sc, o1[4 * q + 3] * sc);
  }
}

template <int QT, int DT, bool SHIFT>
DI void flash_run(f32x16 (&O)[QT][DT], float (&ls)[QT], const bf16_t* Qp, int ldq, const bf16_t* Kp, int ldk, const bf16_t* Vtp,
                  float negc, char* smem) {
  constexpr int STG = 9216 + DT * 32 * 144;
  const int tid = tidx(), lane = tid & 63, w = tid >> 6, r = lane & 31, h = lane >> 5;
  bf16x8 qf[QT][4];
#pragma unroll
  for (int qt = 0; qt < QT; ++qt)
#pragma unroll
    for (int kk = 0; kk < 4; ++kk) qf[qt][kk] = ld_frag(Qp + (long)(w * (32 * QT) + qt * 32 + r) * ldq + kk * 16 + 8 * h);
#pragma unroll
  for (int qt = 0; qt < QT; ++qt) {
    ls[qt] = 0.f;
#pragma unroll
    for (int dt = 0; dt < DT; ++dt) O[qt][dt] = splat16(0.f);
  }
  u32x4 sk[1], sv[DT / 2];
  const int srow = tid >> 3, skc = tid & 7;
  const bf16_t* ksrc = Kp + (long)srow * ldk + skc * 8;
  const bf16_t* vsrc = Vtp + (long)srow * VTS + skc * 8;
  const int slo = srow * 144 + skc * 16;
  const int koff = kperm(r) * 144 + h * 16;
  const int voff = 9216 + aperm(r) * 144 + h * 16;
  sk[0] = *(const u32x4*)(ksrc);
#pragma unroll
  for (int j = 0; j < DT / 2; ++j) sv[j] = *(const u32x4*)(vsrc + (long)(64 * j) * VTS);
  __syncthreads();
  *(u32x4*)(smem + slo) = sk[0];
#pragma unroll
  for (int j = 0; j < DT / 2; ++j) *(u32x4*)(smem + 9216 + slo + j * 64 * 144) = sv[j];
  sk[0] = *(const u32x4*)(ksrc + (long)64 * ldk);
#pragma unroll
  for (int j = 0; j < DT / 2; ++j) sv[j] = *(const u32x4*)(vsrc + (long)(64 * j) * VTS + 64);
  __syncthreads();
  constexpr int NKT = S / 64;
  for (int kt = 0; kt < NKT; ++kt) {
    char* db = smem + ((kt + 1) & 1) * STG;
    const int key0 = (kt + 2 < NKT ? kt + 2 : NKT - 1) * 64;
    const char* sb = smem + (kt & 1) * STG;
#pragma unroll
    for (int ksub = 0; ksub < 2; ++ksub) {
      bf16x8 kf[4], vf[DT][2];
#pragma unroll
      for (int kk = 0; kk < 4; ++kk) kf[kk] = ld_frag(sb + koff + ksub * 32 * 144 + kk * 32);
#pragma unroll
      for (int dt = 0; dt < DT; ++dt)
#pragma unroll
        for (int s2 = 0; s2 < 2; ++s2) vf[dt][s2] = ld_frag(sb + voff + dt * 32 * 144 + (ksub * 32 + 16 * s2) * 2);
      __builtin_amdgcn_sched_barrier(0);
      bf16x8 pf[QT][2];
#pragma unroll
      for (int qt = 0; qt < QT; ++qt) {
        f32x16 sx = splat16(SHIFT ? negc : 0.f);
#pragma unroll
        for (int kk = 0; kk < 4; ++kk) sx = mfma(kf[kk], qf[qt][kk], sx);
        float lsum = 0.f;
#pragma unroll
        for (int e = 0; e < 16; ++e) { sx[e] = __builtin_amdgcn_exp2f(sx[e]); lsum += sx[e]; }
        ls[qt] += lsum;
        pf[qt][0] = packP<0>(sx); pf[qt][1] = packP<1>(sx);
      }
      if (ksub == 0) {
        *(u32x4*)(db + slo) = sk[0];
        sk[0] = *(const u32x4*)(ksrc + (long)key0 * ldk);
      } else {
#pragma unroll
        for (int j = 0; j < DT / 2; ++j) *(u32x4*)(db + 9216 + slo + j * 64 * 144) = sv[j];
#pragma unroll
        for (int j = 0; j < DT / 2; ++j) sv[j] = *(const u32x4*)(vsrc + (long)(64 * j) * VTS + key0);
      }
#pragma unroll
      for (int dt = 0; dt < DT; ++dt)
#pragma unroll
        for (int s2 = 0; s2 < 2; ++s2)
#pragma unroll
          for (int qt = 0; qt < QT; ++qt) O[qt][dt] = mfma(vf[dt][s2], pf[qt][s2], O[qt][dt]);
    }
    __syncthreads();
  }
}

DI void attn_c_task(const Params& P, int task, char* smem) {
  const int hq = task >> 5, qb = task & 31, q0 = qb * 512;
  const int lane = tidx() & 63, w = tidx() >> 6, r = lane & 31, h = lane >> 5;
  const float negc = -((const float*)(P.ws + OFF_SC))[1];
  f32x16 O[2][2]; float ls[2];
  const bf16_t* Qp = (const bf16_t*)(P.ws + OFF_QC) + (long)q0 * LDQ + hq * 64;
  const bf16_t* Kp = (const bf16_t*)(P.ws + OFF_KC) + (hq >> 2) * 64;
  const bf16_t* Vp = (const bf16_t*)(P.ws + OFF_VTC) + (long)((hq >> 2) * 64) * VTS;
  if (negc < -64.f) flash_run<2, 2, true>(O, ls, Qp, LDQ, Kp, 128, Vp, negc, smem);
  else flash_run<2, 2, false>(O, ls, Qp, LDQ, Kp, 128, Vp, negc, smem);
  const bf16_t* gate = (const bf16_t*)(P.ws + OFF_GATE);
  bf16_t* mixed = (bf16_t*)(P.ws + OFF_MIXED);
#pragma unroll
  for (int qt = 0; qt < 2; ++qt) {
    const float l = ls[qt] + __shfl_xor(ls[qt], 32);
    const float inv = 1.f / l;
    const int t = q0 + w * 64 + qt * 32 + r;
#pragma unroll
    for (int dt = 0; dt < 2; ++dt) {
      const long off = (long)t * LDH + 1024 + hq * 64 + dt * 32 + 16 * h;
      float g[16], v[16];
      unpack8(*(const uint4*)(gate + off), g); unpack8(*(const uint4*)(gate + off + 8), g + 8);
#pragma unroll
      for (int i = 0; i < 16; ++i) v[i] = O[qt][dt][i] * inv * g[i];
      *(uint4*)(mixed + off) = pack8(v); *(uint4*)(mixed + off + 8) = pack8(v + 8);
    }
  }
}

DI void attn_d_task(const Params& P, int task, char* smem) {
  const int inst = task >> 6, qb = task & 63, q0 = qb * 256, hh = inst >> 1, c = inst & 1;
  const int lane = tidx() & 63, w = tidx() >> 6, r = lane & 31, h = lane >> 5;
  const float negc = -((const float*)(P.ws + OFF_SC))[2];
  f32x16 O[1][4]; float ls[1];
  const bf16_t* Qp = (const bf16_t*)(P.ws + OFF_QD) + (long)q0 * LDQ + inst * 64;
  const bf16_t* Kp = (const bf16_t*)(P.ws + OFF_KD) + inst * 64;
  const bf16_t* Vp = (const bf16_t*)(P.ws + OFF_VTD) + (long)(hh * 128) * VTS;
  if (negc < -64.f) flash_run<1, 4, true>(O, ls, Qp, LDQ, Kp, LDQ, Vp, negc, smem);
  else flash_run<1, 4, false>(O, ls, Qp, LDQ, Kp, LDQ, Vp, negc, smem);
  float* dtmp = (float*)(P.ws + OFF_DTMP) + (long)c * S * 512;
  {
    const float l = ls[0] + __shfl_xor(ls[0], 32);
    const float inv = 1.f / l;
    float* strip = epi_strip(smem);
#pragma unroll
    for (int half = 0; half < 2; ++half) {
      epi_park_o(strip, O[0][2 * half], O[0][2 * half + 1], inv);
#pragma unroll 4
      for (int j = 0; j < 8; ++j) {
        const int row = 4 * j + (lane >> 4), c4 = (lane & 15) * 4;
        const int t = q0 + w * 32 + row;
        *(float4*)(dtmp + (long)t * 512 + hh * 128 + half * 64 + c4) = *(const float4*)(strip + row * EPI_PITCH + c4);
      }
    }
  }
}

template <int DIL, int NSUB>
DI void band_pattern(f32x16 (&O)[2], float& lsum, const bf16x8 (&qf)[4], const bf16_t* Kp  , const bf16_t* Vt  ,
                     int rho, int mstart, int mq, float negc, char* strip) {
  constexpr int ND = S / DIL;
  const int lane = tidx() & 63, r = lane & 31, h = lane >> 5;
  const int krow = lane >> 3, kch = lane & 7, vrow = lane >> 2, vch = lane & 3;
  char* Ks = strip; char* Vs = strip + 32 * 144;
  u32x4 kreg[4], vreg[4];
#define BP_FETCH(SUB) { const int ms_ = mstart + 32 * (SUB); \
    _Pragma("unroll") for (int j = 0; j < 4; ++j) { \
      int m_ = ms_ + krow + 8 * j; m_ = m_ < 0 ? 0 : (m_ > ND - 1 ? ND - 1 : m_); \
      kreg[j] = *(const u32x4*)(Kp + (long)(rho + DIL * m_) * LDQ + kch * 8); } \
    int mc_ = ms_ + vch * 8; mc_ = mc_ < 0 ? 0 : (mc_ > ND - 8 ? ND - 8 : mc_); \
    _Pragma("unroll") for (int j = 0; j < 4; ++j) vreg[j] = *(const u32x4*)(Vt + (long)(vrow + 16 * j) * VTS + rho * ND + mc_); }
  BP_FETCH(0)
  const int koff = kperm(r) * 144 + h * 16, voff = aperm(r) * 80 + h * 16;
  for (int sub = 0; sub < NSUB; ++sub) {
    const int ms = mstart + 32 * sub;
#pragma unroll
    for (int j = 0; j < 4; ++j) *(u32x4*)(Ks + (krow + 8 * j) * 144 + kch * 16) = kreg[j];
#pragma unroll
    for (int j = 0; j < 4; ++j) *(u32x4*)(Vs + (vrow + 16 * j) * 80 + vch * 16) = vreg[j];
    { const int ns = sub + 1 < NSUB ? sub + 1 : NSUB - 1; BP_FETCH(ns) }
    bf16x8 kf[4], vf[2][2];
#pragma unroll
    for (int kk = 0; kk < 4; ++kk) kf[kk] = ld_frag(Ks + koff + kk * 32);
#pragma unroll
    for (int dt = 0; dt < 2; ++dt)
#pragma unroll
      for (int s2 = 0; s2 < 2; ++s2) vf[dt][s2] = ld_frag(Vs + voff + dt * 32 * 80 + s2 * 32);
    f32x16 sx = splat16(negc);
#pragma unroll
    for (int kk = 0; kk < 4; ++kk) sx = mfma(kf[kk], qf[kk], sx);
#pragma unroll
    for (int e = 0; e < 16; ++e) {
      const int me = ms + 16 * (e >> 3) + 8 * h + (e & 7);
      const int dd = me - mq;
      const bool valid = (dd <= 64) && (dd >= -64) && (me >= 0) && (me < ND);
      sx[e] = valid ? __builtin_amdgcn_exp2f(sx[e]) : 0.f;
      lsum += sx[e];
    }
    bf16x8 pf[2];
    pf[0] = packP<0>(sx); pf[1] = packP<1>(sx);
#pragma unroll
    for (int s2 = 0; s2 < 2; ++s2)
#pragma unroll
      for (int dt = 0; dt < 2; ++dt) O[dt] = mfma(vf[dt][s2], pf[s2], O[dt]);
  }
#undef BP_FETCH
}

template <int DIL, int PASS>
DI void attn_a_pass(const Params& P, int wt, char* smem) {
  const int lane = tidx() & 63, r = lane & 31, h = lane >> 5;
  const int head = wt >> 9, rem = wt & 511, rho = rem & (DIL - 1), b = rem / DIL;
  const float negc = -((const float*)(P.ws + OFF_SC))[0];
  const int mq = 32 * b + r, pos = rho + DIL * mq;
  const bf16_t* qa = (const bf16_t*)(P.ws + OFF_QA) + (long)pos * LDQ + head * 64 + 8 * h;
  bf16x8 qf[4];
#pragma unroll
  for (int kk = 0; kk < 4; ++kk) qf[kk] = ld_frag(qa + kk * 16);
  const bf16_t* Kp = (const bf16_t*)(P.ws + OFF_KA) + head * 64;
  const bf16_t* Vt = (const bf16_t*)(P.ws + OFF_VTA) + (long)(DIL == 1 ? 0 : (DIL == 4 ? 512 : 1024)) * VTS + (long)(head * 64) * VTS;
  f32x16 O[2]; O[0] = splat16(0.f); O[1] = splat16(0.f);
  float lsum = 0.f;
  band_pattern<DIL, 5>(O, lsum, qf, Kp, Vt, rho, 32 * b - 64, mq, negc, smem + (tidx() >> 6) * 9728);
  float l = lsum + __shfl_xor(lsum, 32);
  float* ol = (float*)(P.ws + OFF_AOL) + (long)pos * 8 + head;
  if (PASS > 0) l += *ol;
  if (PASS < 2 && h == 0) *ol = l;
  float* strip = (float*)(smem + (tidx() >> 6) * 9728);
  epi_park_o(strip, O[0], O[1], 1.f);
  const bf16_t* gate = (const bf16_t*)(P.ws + OFF_GATE);
  bf16_t* mixed = (bf16_t*)(P.ws + OFF_MIXED);
#pragma unroll 4
  for (int j = 0; j < 8; ++j) {
    const int row = 4 * j + (lane >> 4), c4 = (lane & 15) * 4;
    const int prow = rho + DIL * (32 * b + row);
    float4 a = *(const float4*)(strip + row * EPI_PITCH + c4);
    float* oa = (float*)(P.ws + OFF_AOA) + ((long)prow * 8 + head) * 64 + c4;
    if (PASS > 0) { const float4 pv = *(const float4*)oa; a.x += pv.x; a.y += pv.y; a.z += pv.z; a.w += pv.w; }
    if (PASS < 2) *(float4*)oa = a;
    else {
      const float inv = 1.f / __shfl(l, row);
      const long off = (long)prow * LDH + head * 64 + c4;
      const uint2 gu = *(const uint2*)(gate + off);
      uint2 o;
      o.x = pk2(a.x * inv * __uint_as_float(gu.x << 16), a.y * inv * __uint_as_float(gu.x & 0xffff0000u));
      o.y = pk2(a.z * inv * __uint_as_float(gu.y << 16), a.w * inv * __uint_as_float(gu.y & 0xffff0000u));
      *(uint2*)(mixed + off) = o;
    }
  }
}

DI void s5local_task(const Params& P, int task, char* smem) {
  const int g = task >> 1, mt = task & 1, nt = 0;
  const int lane = tidx() & 63, w = tidx() >> 6, wn = w & 3, wm = w >> 2, r = lane & 31, h = lane >> 5;
  f32x16 acc[2][4]; zero_acc(acc);
  GemmSeg sg{(const bf16_t*)(P.ws + OFF_U) + g * 16, 32 * LDQ, LDQ, (const bf16_t*)(P.ws + OFF_W1) + (long)g * 256 * LDQ, LDQ, 512};
  gemm_kloop(acc, sg, mt * 256, nt * 256, smem);
  float* xl = (float*)(P.ws + OFF_XLOC) + (long)g * 512 * 256;
#pragma unroll
  for (int m4 = 0; m4 < 4; ++m4) {
    const int chunk = mt * 256 + wm * 128 + m4 * 32 + r;
#pragma unroll
    for (int tau = 0; tau < 2; ++tau) {
      float* d = xl + (long)chunk * 256 + nt * 256 + wn * 64 + 32 * h + 16 * tau;
#pragma unroll
      for (int q = 0; q < 4; ++q)
        *(float4*)(d + 4 * q) = make_float4(acc[tau][m4][4 * q], acc[tau][m4][4 * q + 1], acc[tau][m4][4 * q + 2], acc[tau][m4][4 * q + 3]);
    }
  }
}

DI void phase3(const Params& P, char* smem) {
  constexpr int T0 = 512, T1 = T0 + 256, T2 = T1 + 64, T3 = T2 + 512;
  for (int t = blockIdx.x; t < T3; t += gridDim.x) {
    if (t < T0) attn_d_task(P, t, smem);
    else if (t < T1) attn_c_task(P, t - T0, smem);
    else if (t < T2) s5local_task(P, t - T1, smem);
    else attn_a_pass<16, 0>(P, (t - T2) * 8 + (tidx() >> 6), smem);
  }
}

DI void phase4(const Params& P, int li, char* smem) {
  const int lane = tidx() & 63, w = tidx() >> 6;
  const int nw = gridDim.x * 8, gw = blockIdx.x * 8 + w;
  const float* sc = (const float*)(P.ws + OFF_SC);
  const float lam = sc[3], lam_init = sc[4];
  for (int i = blockIdx.x * NT + tidx(); i < 2 * S; i += gridDim.x * NT) ((float*)(P.ws + OFF_RS))[i] = 0.f;
  for (int t = gw; t < 64 + S * 4 + 4096; t += nw) {
    if (t >= 64 + S * 4) {
      attn_a_pass<4, 1>(P, t - (64 + S * 4), smem);
    } else if (t < 64) {
      const int g = t >> 1, dir = t & 1;
      const float2 AT = ((const float2*)(P.ws + OFF_APT))[(dir * 32 + g) * 64 + lane];
      const float* xl = (const float*)(P.ws + OFF_XLOC) + (long)g * 512 * 256 + dir * 128 + lane;
      bf16_t* ci = (bf16_t*)(P.ws + OFF_CIN) + (long)g * 512 * 256 + dir * 128 + lane;
      float xr = 0.f, xi = 0.f;
      for (int s0 = 0; s0 < 512; s0 += 16) {
        float lr[16], lm[16];
#pragma unroll
        for (int u = 0; u < 16; ++u) {
          const int chunk = dir ? 511 - (s0 + u) : s0 + u;
          lr[u] = xl[chunk * 256]; lm[u] = xl[chunk * 256 + 64];
        }
#pragma unroll
        for (int u = 0; u < 16; ++u) {
          const int chunk = dir ? 511 - (s0 + u) : s0 + u;
          ci[chunk * 256] = f2bf(xr); ci[chunk * 256 + 64] = f2bf(xi);
          const float nr = AT.x * xr - AT.y * xi + lr[u], ni = AT.x * xi + AT.y * xr + lm[u];
          xr = nr; xi = ni;
        }
      }
    } else {
      const int tt = (t - 64) >> 2, hh = (t - 64) & 3;
      const long off = (long)tt * 512 + hh * 128 + 2 * lane;
      const float2 o1 = *(const float2*)((const float*)(P.ws + OFF_DTMP) + off);
      const float2 o2 = *(const float2*)((const float*)(P.ws + OFF_DTMP) + (long)S * 512 + off);
      const float a = o1.x - lam * o2.x, b = o1.y - lam * o2.y;
      const float ss = wave_sum(a * a + b * b);
      const float rinv = rsqrtf(ss * (1.f / 128.f) + 1e-6f) * (1.f - lam_init);
      const float2 sw = *(const float2*)(P.d_subln + li * 128 + 2 * lane);
      const long mo = (long)tt * LDH + 1536 + hh * 128 + 2 * lane;
      const unsigned gg = *(const unsigned*)((const bf16_t*)(P.ws + OFF_GATE) + mo);
      const float g0 = __uint_as_float(gg << 16), g1 = __uint_as_float(gg & 0xffff0000u);
      *(unsigned*)((bf16_t*)(P.ws + OFF_MIXED) + mo) = pk2(a * rinv * sw.x * g0, b * rinv * sw.y * g1);
    }
  }
}

DI float gelu_tanh(float y) {
  const float u = 0.7978845608028654f * (y + 0.044715f * y * y * y);
  const float e = __expf(2.f * u);
  const float th = 1.f - 2.f / (e + 1.f);
  return 0.5f * y * (1.f + th);
}

DI void phase5(const Params& P, char* smem) {
  const int lane = tidx() & 63, w = tidx() >> 6, wn = w & 3, wm = w >> 2, r = lane & 31, h = lane >> 5;
  for (int t = blockIdx.x; t < 128 + 512; t += gridDim.x) {
    if (t >= 128) { attn_a_pass<1, 2>(P, (t - 128) * 8 + w, smem); continue; }
    const int g = t >> 2, mt = (t >> 1) & 1, nt = t & 1;
    f32x16 acc[2][4]; zero_acc(acc);
    const bf16_t* W3 = (const bf16_t*)(P.ws + OFF_W3) + (long)g * 512 * 1280;
    const bf16_t* U = (const bf16_t*)(P.ws + OFF_U) + g * 16;
    GemmSeg s0{U, 32 * LDQ, LDQ, W3, 1280, 512};
    gemm_kloop(acc, s0, mt * 256, nt * 256, smem);
    GemmSeg s1{U, 32 * LDQ, LDQ, W3 + 512, 1280, 512};
    gemm_kloop(acc, s1, mt * 256, nt * 256, smem);
    GemmSeg s2{(const bf16_t*)(P.ws + OFF_CIN) + (long)g * 512 * 256, 256, 16, W3 + 1024, 1280, 256};
    gemm_kloop(acc, s2, mt * 256, nt * 256, smem);
    bf16_t* yb = (bf16_t*)(P.ws + OFF_Y);
#pragma unroll
    for (int m4 = 0; m4 < 4; ++m4) {
      const int chunk = mt * 256 + wm * 128 + m4 * 32 + r;
#pragma unroll
      for (int tau = 0; tau < 2; ++tau) {
        const int n = nt * 256 + wn * 64 + 32 * h + 16 * tau;
        const int jo = n >> 4;
        float v[16];
#pragma unroll
        for (int i = 0; i < 16; ++i) v[i] = gelu_tanh(acc[tau][m4][i]);
        bf16_t* d = yb + (long)(chunk * 32 + jo) * LDQ + g * 16;
        *(uint4*)d = pack8(v); *(uint4*)(d + 8) = pack8(v + 8);
      }
    }
  }
}

DI void phase6(const Params& P, int li, char* smem) {
  const int lane = tidx() & 63, w = tidx() >> 6, wn = w & 3, wm = w >> 2, r = lane & 31, h = lane >> 5;
  for (int t = blockIdx.x; t < 64 * 4; t += gridDim.x) {
    const int nt = t >> 6, mt = t & 63;
    f32x16 acc[2][4]; zero_acc(acc);
    GemmSeg sg{(const bf16_t*)(P.ws + OFF_Y), LDQ, 16, (const bf16_t*)(P.ws + OFF_WTGLU), LDQ, 512};
    gemm_kloop(acc, sg, mt * 256, nt * 256, smem);
    const int colb = ((nt * 256 + wn * 64 + 32 * h) >> 5) * 16;
    const float* bg = P.b_glu + li * 1024;
    const bf16_t* gate = (const bf16_t*)(P.ws + OFF_GATE);
    bf16_t* mixed = (bf16_t*)(P.ws + OFF_MIXED);
#pragma unroll
    for (int m4 = 0; m4 < 4; ++m4) {
      const int tok = mt * 256 + wm * 128 + m4 * 32 + r;
      const long off = (long)tok * LDH + 512 + colb;
      float g[16], v[16];
      unpack8(*(const uint4*)(gate + off), g); unpack8(*(const uint4*)(gate + off + 8), g + 8);
#pragma unroll
      for (int i = 0; i < 16; ++i) {
        const float z1 = acc[0][m4][i] + bg[colb + i], z2 = acc[1][m4][i] + bg[512 + colb + i];
        v[i] = z1 * sigmoidf_(z2) * g[i];
      }
      *(uint4*)(mixed + off) = pack8(v); *(uint4*)(mixed + off + 8) = pack8(v + 8);
    }
  }
}

DI void phase7(const Params& P, int li, char* smem) {
  const int lane = tidx() & 63, w = tidx() >> 6, wn = w & 3, wm = w >> 2, r = lane & 31, h = lane >> 5;
  const float* xs = li == 0 ? P.x : P.out;
  for (int t = blockIdx.x; t < 512; t += gridDim.x) {
    const int tt = t & 511, nt = tt >> 6, mt = tt & 63;
    f32x16 acc[2][4]; zero_acc(acc);
    {
      GemmSeg sg{(const bf16_t*)(P.ws + OFF_MIXED), LDH, 16, (const bf16_t*)(P.ws + ((li & 1) ? OFF_WTOUT2 : OFF_WTOUT)), LDH, DM};
      gemm_kloop(acc, sg, mt * 256, nt * 256, smem);
      float* strip = epi_strip(smem);
#pragma unroll
      for (int m4 = 0; m4 < 4; ++m4) {
        epi_park(strip, acc[0][m4], acc[1][m4]);
#pragma unroll 2
        for (int j = 0; j < 8; ++j) {
          const int row = 4 * j + (lane >> 4), c4 = (lane & 15) * 4;
          const int tok = mt * 256 + wm * 128 + m4 * 32 + row;
          const float4 a = *(const float4*)(strip + row * EPI_PITCH + c4);
          const long off = (long)tok * DM + nt * 256 + wn * 64 + c4;
          const float4 xv = *(const float4*)(xs + off);
          const float4 xn = make_float4(xv.x + a.x, xv.y + a.y, xv.z + a.z, xv.w + a.w);
          *(float4*)(P.out + off) = xn;
          uint2 hb2; hb2.x = pk2(xn.x, xn.y); hb2.y = pk2(xn.z, xn.w);
          *(uint2*)((bf16_t*)(P.ws + OFF_H2) + (long)tok * LDH + nt * 256 + wn * 64 + c4) = hb2;
          float ssq = xn.x * xn.x + xn.y * xn.y + xn.z * xn.z + xn.w * xn.w;
          ssq += __shfl_xor(ssq, 1); ssq += __shfl_xor(ssq, 2); ssq += __shfl_xor(ssq, 4); ssq += __shfl_xor(ssq, 8);
          if ((lane & 15) == 0) atomicAdd((float*)(P.ws + OFF_RS) + S + tok, ssq);
        }
      }
    }
  }
}

DI void phase9(const Params& P, int li, char* smem) {
  const int lane = tidx() & 63, w = tidx() >> 6, wn = w & 3, wm = w >> 2, r = lane & 31, h = lane >> 5;
  for (int t = blockIdx.x; t < 512; t += gridDim.x) {
    const int nt = t >> 6, mt = t & 63;
    f32x16 acc[2][4]; zero_acc(acc);
    GemmSeg sg{(const bf16_t*)(P.ws + OFF_H2), LDH, 16, (const bf16_t*)(P.ws + ((li & 1) ? OFF_WTGATE2 : OFF_WTGATE)), LDH, DM};
    gemm_kloop(acc, sg, mt * 256, nt * 256, smem);
    const bf16_t* pe = (const bf16_t*)(P.ws + OFF_PE);
    float* strip = epi_strip(smem);
#pragma unroll
    for (int m4 = 0; m4 < 4; ++m4) {
      epi_park(strip, acc[0][m4], acc[1][m4]);
#pragma unroll 2
      for (int j = 0; j < 8; ++j) {
        const int row = 4 * j + (lane >> 4), c4 = (lane & 15) * 4;
        const int tok = mt * 256 + wm * 128 + m4 * 32 + row;
        const float rin = rsqrtf(((const float*)(P.ws + OFF_RS))[S + tok] * (1.f / DM) + 1e-6f);
        const float4 a = *(const float4*)(strip + row * EPI_PITCH + c4);
        const long off = (long)tok * DM + nt * 256 + wn * 64 + c4;
        const float4 xv = *(const float4*)(P.out + off);
        const uint2 pu = *(const uint2*)(pe + off);
        const float e0 = __uint_as_float(pu.x << 16), e1 = __uint_as_float(pu.x & 0xffff0000u);
        const float e2 = __uint_as_float(pu.y << 16), e3 = __uint_as_float(pu.y & 0xffff0000u);
        const float4 xn = make_float4(xv.x + sigmoidf_(a.x * rin) * e0, xv.y + sigmoidf_(a.y * rin) * e1,
                                      xv.z + sigmoidf_(a.z * rin) * e2, xv.w + sigmoidf_(a.w * rin) * e3);
        *(float4*)(P.out + off) = xn;
        uint2 hb2; hb2.x = pk2(xn.x, xn.y); hb2.y = pk2(xn.z, xn.w);
        *(uint2*)((bf16_t*)(P.ws + OFF_H) + (long)tok * LDH + nt * 256 + wn * 64 + c4) = hb2;
        float ssq = xn.x * xn.x + xn.y * xn.y + xn.z * xn.z + xn.w * xn.w;
        ssq += __shfl_xor(ssq, 1); ssq += __shfl_xor(ssq, 2); ssq += __shfl_xor(ssq, 4); ssq += __shfl_xor(ssq, 8);
        if ((lane & 15) == 0) atomicAdd((float*)(P.ws + OFF_RS) + tok, ssq);
      }
    }
  }
}

#define XB_TMO      128
#define XB_XCNT(j)  (256  + 64 * (j))
#define XB_XSUB(j)  (1280 + 64 * (j))
#define XB_XGEN(j)  (2304 + 64 * (j))
#define XB_TOP      3328
#define XB_TOPGEN   3392
#define XCD_BAR_WORDS 3456
#define XB_SPIN_CAP (1u << 20)
#define LAS __attribute__((address_space(3)))
DI unsigned xb_ld(unsigned* p) { return __hip_atomic_load(p, __ATOMIC_RELAXED, __HIP_MEMORY_SCOPE_AGENT); }
DI unsigned xb_add(unsigned* p, unsigned v) { return __hip_atomic_fetch_add(p, v, __ATOMIC_RELAXED, __HIP_MEMORY_SCOPE_AGENT); }
DI unsigned xb_xcc_id() { return (unsigned)__builtin_amdgcn_s_getreg((3 << 11) | 20) & 0xFu; }
#define XB_SPIN(cond, bar) do { unsigned _sp = 0; while (cond) { __builtin_amdgcn_s_sleep(1); \
    if ((++_sp & 255u) == 0u) { if (xb_ld(&(bar)[XB_TMO])) break; if (_sp > XB_SPIN_CAP) { atomicAdd(&(bar)[XB_TMO], 1u); break; } } } } while (0)
struct XcdBarrier { unsigned* bar; unsigned x; volatile LAS unsigned* st; };
DI XcdBarrier xcd_barrier_post(unsigned* bar, volatile LAS unsigned* st) {
  XcdBarrier b; b.bar = bar; b.x = xb_xcc_id(); b.st = st;
  if (threadIdx.x == 0) (void)xb_add(&bar[XB_XCNT(b.x)], 1u);
  return b;
}
DI void xcd_barrier_complete(unsigned* bar, unsigned x, unsigned& nloc, unsigned& nx) {
  const unsigned G = gridDim.x * gridDim.y * gridDim.z;
  unsigned sum, cnt, mine, sp = 0u;
  for (;;) {
    sum = 0u; cnt = 0u; mine = 0u;
#pragma unroll
    for (unsigned j = 0; j < 16; ++j) { const unsigned c = xb_ld(&bar[XB_XCNT(j)]); sum += c; cnt += (c > 0u) ? 1u : 0u; mine = (j == x) ? c : mine; }
    if (sum == G) break;
    __builtin_amdgcn_s_sleep(1);
    if ((++sp & 255u) == 0u) { if (xb_ld(&bar[XB_TMO])) break; if (sp > XB_SPIN_CAP) { atomicAdd(&bar[XB_TMO], 1u); break; } }
  }
  nloc = mine > 0u ? mine : 1u; nx = cnt > 0u ? cnt : 1u;
}
DI void xcd_barrier(const XcdBarrier& b) {
  asm volatile("s_waitcnt vmcnt(0)" ::: "memory");
  __syncthreads();
  if (threadIdx.x == 0) {
    unsigned* bar = b.bar;
    __builtin_amdgcn_s_waitcnt(0);
    unsigned nloc = b.st[0], nx = b.st[1];
    if (nloc == 0u) { xcd_barrier_complete(bar, b.x, nloc, nx); b.st[0] = nloc; b.st[1] = nx; }
    const unsigned old = xb_add(&bar[XB_XSUB(b.x)], 1u);
    const unsigned gen = old / nloc;
    if (old + 1u == (gen + 1u) * nloc) {
      __builtin_amdgcn_fence(__ATOMIC_RELEASE, "agent");
      asm volatile("s_waitcnt vmcnt(0)" ::: "memory");
      const unsigned og = xb_add(&bar[XB_TOP], 1u);
      const unsigned tg = og / nx;
      if (og + 1u == (tg + 1u) * nx) xb_add(&bar[XB_TOPGEN], 1u);
      else XB_SPIN(xb_ld(&bar[XB_TOPGEN]) == tg, bar);
      __builtin_amdgcn_fence(__ATOMIC_ACQUIRE, "agent");
      xb_add(&bar[XB_XGEN(b.x)], 1u);
      asm volatile("s_waitcnt vmcnt(0)" ::: "memory");
    } else {
      XB_SPIN(xb_ld(&bar[XB_XGEN(b.x)]) == gen, bar);
      __builtin_amdgcn_fence(__ATOMIC_ACQUIRE, "agent");
      asm volatile("s_waitcnt vmcnt(0)" ::: "memory");
    }
  }
  __syncthreads();
}

constexpr int DYN_LDS = 2 * G_STAGE;
__global__ void __launch_bounds__(512, 2) hybrid_fwd(Params P) {
  extern __shared__ __attribute__((aligned(16))) char smem[];
  __shared__ uint4 xb_words;
  if (threadIdx.x == 0) xb_words = make_uint4(0u, 0u, 0u, 0u);
  __syncthreads();
  const XcdBarrier xb = xcd_barrier_post((unsigned*)(P.ws + OFF_BAR), (volatile LAS unsigned*)&xb_words);
  if (P.out == nullptr) cg::this_grid().sync();
  for (int li = 0; li < NLAYER; ++li) {
    phase1(P, li, smem); xcd_barrier(xb);
    phase2(P, li, smem); xcd_barrier(xb);
    phase3(P, smem); xcd_barrier(xb);
    phase4(P, li, smem); xcd_barrier(xb);
    phase5(P, smem); xcd_barrier(xb);
    phase6(P, li, smem); xcd_barrier(xb);
    phase7(P, li, smem); xcd_barrier(xb);
    phase9(P, li, smem); xcd_barrier(xb);
  }
}

extern "C" void kernel_launch(void* const* d_in, const int* in_sizes, int n_in, void* d_out, int out_size, void* d_ws, size_t ws_size,
                              hipStream_t stream) {
  static int grid_blocks = 0;
  if (!grid_blocks) {
    int dev = 0, cus = 0, per_cu = 0;
    hipGetDevice(&dev);
    hipDeviceGetAttribute(&cus, hipDeviceAttributeMultiprocessorCount, dev);
    hipFuncSetAttribute((const void*)hybrid_fwd, hipFuncAttributeMaxDynamicSharedMemorySize, DYN_LDS);
    hipOccupancyMaxActiveBlocksPerMultiprocessor(&per_cu, hybrid_fwd, NT, DYN_LDS);
    per_cu = 1;
    grid_blocks = cus * per_cu;
  }
  if (ws_size < WS_TOTAL) fprintf(stderr, "workspace too small: %zu < %zu\n", ws_size, (size_t)WS_TOTAL);
  Params P{};
  const float** pp = (const float**)&P;
  for (int i = 0; i < 29; ++i) pp[i] = (const float*)d_in[i];
  P.out = (float*)d_out;
  P.ws = (char*)d_ws;
  hipMemsetAsync((char*)d_ws + OFF_BAR, 0, 4096 * 4, stream);
  void* args[] = {&P};
  hipError_t e = hipLaunchCooperativeKernel((void*)hybrid_fwd, dim3(grid_blocks), dim3(NT), args, DYN_LDS, stream);
  if (e != hipSuccess) fprintf(stderr, "cooperative launch failed: %s (grid %d)\n", hipGetErrorString(e), grid_blocks);
}
```

```cpp
#include <hip/hip_runtime.h>
#include <hip/hip_cooperative_groups.h>
#include <cstdio>
namespace cg = cooperative_groups;

#define DI __device__ __forceinline__
typedef unsigned short bf16_t;
using bf16x8 = __attribute__((ext_vector_type(8))) short;
using f32x16 = __attribute__((ext_vector_type(16))) float;
typedef __attribute__((ext_vector_type(2))) float f32x2_t;
typedef __attribute__((ext_vector_type(4))) unsigned u32x4;
typedef __attribute__((ext_vector_type(2))) __bf16 bf16x2_t;

constexpr int S = 16384;
constexpr int DM = 2048;
constexpr int NC = 6400;
constexpr int NLAYER = 4;
constexpr float LOG2E = 1.4426950408889634f;
constexpr float QSCALE = 0.125f * LOG2E;
constexpr int LDH = DM + 64;
constexpr int LDQ = 512 + 64;
constexpr int VTS = S + 64;

constexpr size_t al(size_t x) { return (x + 255) & ~(size_t)255; }
constexpr size_t OFF_WTIN = 0;
constexpr size_t OFF_WTOUT = OFF_WTIN + al((size_t)NC * LDH * 2);
constexpr size_t OFF_WTGATE = OFF_WTOUT + al((size_t)DM * LDH * 2);
constexpr size_t OFF_WTPLE = OFF_WTGATE + al((size_t)DM * LDH * 2);
constexpr size_t OFF_WTGLU = OFF_WTPLE + al((size_t)DM * 256 * 2);
constexpr size_t OFF_PBF = OFF_WTGLU + al((size_t)1024 * LDQ * 2);
constexpr size_t OFF_W1 = OFF_PBF + al((size_t)S * 256 * 2);
constexpr size_t OFF_W3 = OFF_W1 + al((size_t)32 * 256 * LDQ * 2);
constexpr size_t OFF_APT = OFF_W3 + al((size_t)32 * 512 * 1280 * 2);
constexpr size_t OFF_SC = OFF_APT + al((size_t)2 * 32 * 64 * 8);
constexpr size_t OFF_COS1 = OFF_SC + al(64);
constexpr size_t OFF_SIN1 = OFF_COS1 + al((size_t)S * 8 * 4);
constexpr size_t OFF_AXT = OFF_SIN1 + al((size_t)S * 8 * 4);
constexpr size_t OFF_H = OFF_AXT + al((size_t)(256 + 256 + 64 + 64) * 16 * 4);
constexpr size_t OFF_QA = OFF_H + al((size_t)S * LDH * 2);
constexpr size_t OFF_KA = OFF_QA + al((size_t)S * LDQ * 2);
constexpr size_t OFF_VTA = OFF_KA + al((size_t)S * LDQ * 2);
constexpr size_t OFF_QC = OFF_VTA + al((size_t)3 * 512 * VTS * 2);
constexpr size_t OFF_KC = OFF_QC + al((size_t)S * LDQ * 2);
constexpr size_t OFF_VTC = OFF_KC + al((size_t)S * 128 * 2);
constexpr size_t OFF_QD = OFF_VTC + al((size_t)128 * VTS * 2);
constexpr size_t OFF_KD = OFF_QD + al((size_t)S * LDQ * 2);
constexpr size_t OFF_VTD = OFF_KD + al((size_t)S * LDQ * 2);
constexpr size_t OFF_GATE = OFF_VTD + al((size_t)512 * VTS * 2);
constexpr size_t OFF_U = OFF_GATE + al((size_t)S * LDH * 2);
constexpr size_t OFF_XLOC = OFF_U + al((size_t)S * LDQ * 2);
constexpr size_t OFF_CIN = OFF_XLOC + al((size_t)32 * 512 * 256 * 4);
constexpr size_t OFF_DTMP = OFF_CIN + al((size_t)32 * 512 * 256 * 2);
constexpr size_t OFF_Y = OFF_DTMP + al((size_t)2 * S * 512 * 4);
constexpr size_t OFF_MIXED = OFF_Y + al((size_t)S * LDQ * 2);
constexpr size_t OFF_PE = OFF_MIXED + al((size_t)S * LDH * 2);
constexpr size_t OFF_BAR = OFF_PE + al((size_t)S * DM * 2);
constexpr size_t OFF_H2 = OFF_BAR + al(4096 * 4);
constexpr size_t OFF_RS = OFF_H2 + al((size_t)S * LDH * 2);
constexpr size_t OFF_AOA = OFF_RS + al((size_t)2 * S * 4);
constexpr size_t OFF_AOL = OFF_AOA + al((size_t)S * 512 * 4);
constexpr size_t OFF_WTOUT2 = OFF_AOL + al((size_t)S * 8 * 4);
constexpr size_t OFF_WTGATE2 = OFF_WTOUT2 + al((size_t)DM * LDH * 2);
constexpr size_t WS_TOTAL = OFF_WTGATE2 + al((size_t)DM * LDH * 2);

struct Params {
  const float* x; const float* p; const float* norm_w; const float* w_in; const float* w_out;
  const float* a_q_norm; const float* a_k_norm;
  const float* lam_re; const float* lam_im; const float* log_dt; const float* b_re; const float* b_im;
  const float* c_re; const float* c_im; const float* s5_d; const float* w_glu; const float* b_glu;
  const float* c_q_norm; const float* c_k_norm; const float* d_q_norm; const float* d_k_norm;
  const float* lq1; const float* lk1; const float* lq2; const float* lk2; const float* d_subln;
  const float* ple_norm_w; const float* ple_gate_w; const float* ple_w;
  float* out; char* ws;
};

DI int tidx() { int t = __builtin_amdgcn_workitem_id_x(); asm volatile("" : "+v"(t)); return t; }
DI unsigned pk2(float a, float b) { f32x2_t v = {a, b}; bf16x2_t r = __builtin_convertvector(v, bf16x2_t); return __builtin_bit_cast(unsigned, r); }
DI bf16_t f2bf(float a) { return (bf16_t)(pk2(a, 0.f) & 0xffffu); }
DI float bf2f(bf16_t v) { return __uint_as_float(((unsigned)v) << 16); }
DI float wave_sum(float v) { for (int o = 32; o; o >>= 1) v += __shfl_xor(v, o); return v; }
DI float wave_max(float v) { for (int o = 32; o; o >>= 1) v = fmaxf(v, __shfl_xor(v, o)); return v; }
DI f32x16 mfma(bf16x8 a, bf16x8 b, f32x16 c) { return __builtin_amdgcn_mfma_f32_32x32x16_bf16(a, b, c, 0, 0, 0); }
DI f32x16 splat16(float v) { f32x16 r; for (int i = 0; i < 16; ++i) r[i] = v; return r; }
DI uint4 pack8(const float* f) { uint4 u; u.x = pk2(f[0], f[1]); u.y = pk2(f[2], f[3]); u.z = pk2(f[4], f[5]); u.w = pk2(f[6], f[7]); return u; }
DI void unpack8(uint4 u, float* f) {
  f[0] = __uint_as_float(u.x << 16); f[1] = __uint_as_float(u.x & 0xffff0000u);
  f[2] = __uint_as_float(u.y << 16); f[3] = __uint_as_float(u.y & 0xffff0000u);
  f[4] = __uint_as_float(u.z << 16); f[5] = __uint_as_float(u.z & 0xffff0000u);
  f[6] = __uint_as_float(u.w << 16); f[7] = __uint_as_float(u.w & 0xffff0000u);
}
DI bf16x8 ld_frag(const void* p) { return *(const bf16x8*)p; }
template <int S_>
DI bf16x8 packP(const f32x16& p) {
  uint4 u; u.x = pk2(p[8 * S_], p[8 * S_ + 1]); u.y = pk2(p[8 * S_ + 2], p[8 * S_ + 3]); u.z = pk2(p[8 * S_ + 4], p[8 * S_ + 5]); u.w = pk2(p[8 * S_ + 6], p[8 * S_ + 7]);
  return __builtin_bit_cast(bf16x8, u);
}
DI float sigmoidf_(float x) { return 1.f / (1.f + __expf(-x)); }
DI float siluf_(float x) { return x / (1.f + __expf(-x)); }
DI int aperm(int r) { return 16 * ((r >> 2) & 1) + (r & 3) + 4 * (r >> 3); }
DI int kperm(int r) { return (r & 16) | (((r >> 2) & 1) << 3) | (((r >> 3) & 1) << 2) | (r & 3); }

constexpr int NT = 512;
constexpr int G_STAGE = 512 * 128;
struct GemmSeg { const bf16_t* A; long lda; int ks16; const bf16_t* B; long ldb; int K; };

DI void gemm_kloop(f32x16 (&acc)[2][4], const GemmSeg sg, int m0, int n0, char* smem) {
  const int tid = tidx(), lane = tid & 63, w = tid >> 6, wn = w & 3, wm = w >> 2;
  const int r = lane & 31, h = lane >> 5;
  const int srow = tid >> 3, kc = tid & 7;
  const bf16_t* bsrc = sg.B + (long)(n0 + srow) * sg.ldb + kc * 8;
  const bf16_t* asrc = sg.A + (long)(m0 + srow) * sg.lda + (long)(kc >> 1) * sg.ks16 + (kc & 1) * 8;
  const long bstep = 64 * sg.ldb, astep = 64 * sg.lda;
  const int lo = srow * 128 + ((kc ^ ((srow >> 1) & 7)) * 16);
  const int nk = sg.K >> 6;
  u32x4 st[8];
#define G_LOAD(KT) { const int k0_ = (KT) << 6; const long ka_ = (long)(k0_ >> 4) * sg.ks16; \
    st[0] = *(const u32x4*)(bsrc + k0_); st[1] = *(const u32x4*)(bsrc + bstep + k0_); \
    st[2] = *(const u32x4*)(bsrc + 2 * bstep + k0_); st[3] = *(const u32x4*)(bsrc + 3 * bstep + k0_); \
    st[4] = *(const u32x4*)(asrc + ka_); st[5] = *(const u32x4*)(asrc + astep + ka_); \
    st[6] = *(const u32x4*)(asrc + 2 * astep + ka_); st[7] = *(const u32x4*)(asrc + 3 * astep + ka_); }
#define G_WRITE(BUF) { char* d_ = smem + (BUF) * G_STAGE + lo; \
    *(u32x4*)(d_) = st[0]; *(u32x4*)(d_ + 64 * 128) = st[1]; *(u32x4*)(d_ + 128 * 128) = st[2]; *(u32x4*)(d_ + 192 * 128) = st[3]; \
    *(u32x4*)(d_ + 256 * 128) = st[4]; *(u32x4*)(d_ + 320 * 128) = st[5]; *(u32x4*)(d_ + 384 * 128) = st[6]; *(u32x4*)(d_ + 448 * 128) = st[7]; }
  const int woff = (wn * 64 + aperm(r) + 16 * ((r >> 2) & 1)) * 128;
  const int aoff = (256 + wm * 128 + r) * 128;
  const int wsw = ((r >> 1) & 1) + 2 * (r >> 3);
  const int asw = (r >> 1) & 7;
  G_LOAD(0)
  __syncthreads();
  G_WRITE(0)
  G_LOAD(1)
  __syncthreads();
#define G_PART(P_, KT, BUF) { const int k0_ = (KT) << 6; const long ka_ = (long)(k0_ >> 4) * sg.ks16; char* d_ = smem + (BUF) * G_STAGE + lo; \
    *(u32x4*)(d_ + (P_) * 64 * 128) = st[P_]; *(u32x4*)(d_ + (256 + (P_) * 64) * 128) = st[4 + (P_)]; \
    st[P_] = *(const u32x4*)(bsrc + (P_) * bstep + k0_); st[4 + (P_)] = *(const u32x4*)(asrc + (P_) * astep + ka_); }
  for (int kt = 0; kt < nk; ++kt) {
    const int kn = kt + 2 < nk ? kt + 2 : nk - 1;
    const char* sb = smem + (kt & 1) * G_STAGE;
#pragma unroll
    for (int ks = 0; ks < 4; ++ks) {
      bf16x8 wf[2], af[4];
#pragma unroll
      for (int tau = 0; tau < 2; ++tau) wf[tau] = ld_frag(sb + woff + tau * 16 * 128 + (((ks * 2 + h) ^ wsw) * 16));
#pragma unroll
      for (int mt = 0; mt < 4; ++mt) af[mt] = ld_frag(sb + aoff + mt * 32 * 128 + (((ks * 2 + h) ^ asw) * 16));
#pragma unroll
      for (int tau = 0; tau < 2; ++tau)
#pragma unroll
        for (int mt = 0; mt < 4; ++mt) acc[tau][mt] = mfma(wf[tau], af[mt], acc[tau][mt]);
      if (ks == 0) G_PART(0, kn, (kt + 1) & 1)
      if (ks == 1) G_PART(1, kn, (kt + 1) & 1)
      if (ks == 2) G_PART(2, kn, (kt + 1) & 1)
      if (ks == 3) G_PART(3, kn, (kt + 1) & 1)
    }
    __syncthreads();
  }
#undef G_PART
#undef G_LOAD
#undef G_WRITE
}

DI void zero_acc(f32x16 (&acc)[2][4]) {
#pragma unroll
  for (int a = 0; a < 2; ++a)
#pragma unroll
    for (int b = 0; b < 4; ++b) acc[a][b] = splat16(0.f);
}

DI void transpose_task(const float* src, int N, int ldd, bf16_t* dst, int tile, int ntn, bool glu, char* smem, const float* kscale = nullptr) {
  float* tl = (float*)smem;
  const int tid = tidx();
  const int kt = tile / ntn, nt = tile - kt * ntn, k0 = kt * 64, n0 = nt * 64;
  __syncthreads();
#pragma unroll
  for (int j = 0; j < 2; ++j) {
    const int k = (tid >> 4) + 32 * j, n4 = (tid & 15) * 4;
    const float4 v = *(const float4*)(src + (long)(k0 + k) * N + n0 + n4);
    const float sc = kscale ? kscale[k0 + k] : 1.f;
    tl[k * 65 + n4] = v.x * sc; tl[k * 65 + n4 + 1] = v.y * sc; tl[k * 65 + n4 + 2] = v.z * sc; tl[k * 65 + n4 + 3] = v.w * sc;
  }
  __syncthreads();
  {
    const int n = tid >> 3, k8 = (tid & 7) * 8;
    float f[8];
#pragma unroll
    for (int e = 0; e < 8; ++e) f[e] = tl[(k8 + e) * 65 + n];
    const int nsrc = n0 + n;
    const int ndst = glu ? (32 * ((nsrc & 511) >> 4) + 16 * (nsrc >> 9) + (nsrc & 15)) : nsrc;
    *(uint4*)(dst + (long)ndst * ldd + k0 + k8) = pack8(f);
  }
}

DI void sincos_rev(double ang, float& cs, float& sn) {
  const double rev = ang * 0.15915494309189535;
  const float fr = (float)(rev - rint(rev));
  cs = __builtin_amdgcn_cosf(fr); sn = __builtin_amdgcn_sinf(fr);
}
__constant__ double ROPE1_INV[8] = {1.0, 0.19392274474868576, 0.03760603093086393, 0.007292664737217109, 0.001414213562373095, 0.0002742481756762073, 5.318295896944988e-05, 1.031338537721246e-05};
__constant__ double AXIAL_INV[16] = {1.0, 0.5623413251903491, 0.31622776601683794, 0.1778279410038923, 0.1, 0.05623413251903491, 0.03162277660168379, 0.01778279410038923,
                                     0.01, 0.005623413251903491, 0.0031622776601683794, 0.001778279410038923, 0.001, 0.0005623413251903491, 0.00031622776601683794, 0.0001778279410038923};

DI void s5prep_task(const Params& P, int li, int g, int dir, int q, char* smem) {
  float2* Apow = (float2*)smem;
  float2* Bbar = Apow + 33 * 64;
  float2* Cc = Bbar + 64 * 16;
  float* Kt = (float*)(Cc + 16 * 64);
  const int tid = tidx();
  const long gp = (((long)li * 2 + dir) * 32 + g) * 64;
  const float dtf = expf(P.log_dt[(li * 2 + dir) * 32 + g]);
  const double dt = (double)dtf;
  bf16_t* W1 = (bf16_t*)(P.ws + OFF_W1) + (long)g * 256 * LDQ;
  bf16_t* W3 = (bf16_t*)(P.ws + OFF_W3) + (long)g * 512 * 1280;
  float2* apT = (float2*)(P.ws + OFF_APT);
  const float* cre = P.c_re + (((long)li * 2 + dir) * 32 + g) * 16 * 64;
  const float* cim = P.c_im + (((long)li * 2 + dir) * 32 + g) * 16 * 64;
  __syncthreads();
  for (int idx = tid; idx < 33 * 64; idx += NT) {
    const int e = idx >> 6, p = idx & 63;
    const double lr = P.lam_re[gp + p], lim = P.lam_im[gp + p];
    const float mag = expf((float)((double)e * lr * dt));
    float cs, sn; sincos_rev((double)e * lim * dt, cs, sn);
    Apow[idx] = make_float2(mag * cs, mag * sn);
  }
  for (int idx = tid; idx < 64 * 16; idx += NT) {
    const int p = idx >> 4, c = idx & 15;
    const double lr = P.lam_re[gp + p], lim = P.lam_im[gp + p];
    float cs, sn; sincos_rev(lim * dt, cs, sn);
    const double mag = (double)expf((float)(lr * dt)), ar = mag * cs, ai = mag * sn;
    const double den = lr * lr + lim * lim;
    const double cr = ((ar - 1.0) * lr + ai * lim) / den, ci = (ai * lr - (ar - 1.0) * lim) / den;
    const double br = P.b_re[(gp + p) * 16 + c], bi = P.b_im[(gp + p) * 16 + c];
    Bbar[idx] = make_float2((float)(cr * br - ci * bi), (float)(cr * bi + ci * br));
    Cc[idx] = make_float2(cre[idx], cim[idx]);
  }
  __syncthreads();
  if (q == 0 && tid < 64) apT[(dir * 32 + g) * 64 + tid] = Apow[32 * 64 + tid];
  for (int idx = tid; idx < 2048; idx += NT) {
    const int dl = 8 * q + (idx >> 8), co = (idx >> 4) & 15, ci = idx & 15;
    float a = 0.f;
    for (int p = 0; p < 64; ++p) {
      const float2 ap = Apow[dl * 64 + p];
      const float2 cc = Cc[co * 64 + p];
      const float gr = cc.x * ap.x - cc.y * ap.y, gi = cc.x * ap.y + cc.y * ap.x;
      const float2 b = Bbar[p * 16 + ci];
      a += gr * b.x - gi * b.y;
    }
    Kt[idx] = a;
  }
  __syncthreads();
  for (int ch = tid; ch < 128 * 16; ch += NT) {
    const int row = ch >> 4, kc = 16 * q + (ch & 15), part = row >> 6, p = row & 63, j = kc >> 1, c0 = (kc & 1) * 8;
    const int e = dir == 0 ? 31 - j : j;
    const float2 a = Apow[e * 64 + p];
    float f[8];
#pragma unroll
    for (int u = 0; u < 8; ++u) {
      const float2 b = Bbar[p * 16 + c0 + u];
      f[u] = part == 0 ? (a.x * b.x - a.y * b.y) : (a.x * b.y + a.y * b.x);
    }
    *(uint4*)(W1 + (long)(dir * 128 + row) * LDQ + kc * 8) = pack8(f);
  }
  for (int ch = tid; ch < 512 * 64; ch += NT) {
    const int n = ch >> 6, kc = ch & 63, jo = n >> 4, co = n & 15, ji = kc >> 1, ci0 = (kc & 1) * 8;
    const int dl = dir == 0 ? jo - ji : ji - jo;
    const bool mine = dl < 0 ? (q == 0) : ((dl >> 3) == q);
    if (mine) {
      float f[8];
#pragma unroll
      for (int u = 0; u < 8; ++u) {
        float v = 0.f;
        if (dl >= 0) {
          v = Kt[(dl & 7) * 256 + co * 16 + ci0 + u];
          if (dir == 0 && dl == 0 && co == ci0 + u) v += P.s5_d[li * 512 + g * 16 + co];
        }
        f[u] = v;
      }
      *(uint4*)(W3 + (long)n * 1280 + dir * 512 + kc * 8) = pack8(f);
    }
  }
  for (int ch = tid; ch < 128 * 16; ch += NT) {
    const int n = 128 * q + (ch >> 4), pc = ch & 15, part = pc >> 3, p0 = (pc & 7) * 8, jo = n >> 4, co = n & 15;
    const int e = dir == 0 ? jo + 1 : 32 - jo;
    float f[8];
#pragma unroll
    for (int u = 0; u < 8; ++u) {
      const int p = p0 + u;
      const float2 a = Apow[e * 64 + p];
      const float2 cc = Cc[co * 64 + p];
      const float gr = cc.x * a.x - cc.y * a.y, gi = cc.x * a.y + cc.y * a.x;
      f[u] = part == 0 ? gr : -gi;
    }
    *(uint4*)(W3 + (long)n * 1280 + 1024 + dir * 128 + part * 64 + p0) = pack8(f);
  }
}

DI void cvt_rows(const float* xs, bf16_t* hb, float* rs, int row0) {
  const int lane = tidx() & 63, w = tidx() >> 6;
  const int row = row0 + w;
  const float4* xr = (const float4*)(xs + (long)row * DM);
  float ss = 0.f;
#pragma unroll
  for (int j = 0; j < 8; ++j) {
    const float4 v = xr[lane + 64 * j];
    ss += v.x * v.x + v.y * v.y + v.z * v.z + v.w * v.w;
    uint2 o; o.x = pk2(v.x, v.y); o.y = pk2(v.z, v.w);
    *(uint2*)(hb + (long)row * LDH + (lane + 64 * j) * 4) = o;
  }
  ss = wave_sum(ss);
  if (lane == 0) rs[row] = ss;
}

DI void phase1(const Params& P, int li, char* smem) {
  const int tid = tidx();
  bf16_t* hb = (bf16_t*)(P.ws + OFF_H);
  constexpr int T0 = 256, T1 = T0 + 3200, T2 = T1 + 1024, T3 = T2 + 1024, T4 = T3 + 128, T5 = T4 + 128;
  constexpr int T6 = T5 + 2048, T7 = T6 + 1024, T8 = T7 + 1, T9 = T8 + 64;
  const int ntask = li == 0 ? T9 : T8;
  for (int t = blockIdx.x; t < ntask; t += gridDim.x) {
    if (t < T0) s5prep_task(P, li, t >> 3, (t >> 2) & 1, t & 3, smem);
    else if (t < T1) transpose_task(P.w_in + (long)li * DM * NC, NC, LDH, (bf16_t*)(P.ws + OFF_WTIN), t - T0, 100, false, smem, P.norm_w + li * DM);
    else if (t < T2) { if (li == 0) transpose_task(P.w_out, DM, LDH, (bf16_t*)(P.ws + OFF_WTOUT), t - T1, 32, false, smem); }
    else if (t < T3) { if (li == 0) transpose_task(P.ple_gate_w, DM, LDH, (bf16_t*)(P.ws + OFF_WTGATE), t - T2, 32, false, smem, P.ple_norm_w); }
    else if (t < T4) transpose_task(P.ple_w + (long)li * 256 * DM, DM, 256, (bf16_t*)(P.ws + OFF_WTPLE), t - T3, 32, false, smem);
    else if (t < T5) transpose_task(P.w_glu + (long)li * 512 * 1024, 1024, LDQ, (bf16_t*)(P.ws + OFF_WTGLU), t - T4, 16, true, smem);
    else if (t < T6) { if (li == 0) cvt_rows(P.x, hb, (float*)(P.ws + OFF_RS), (t - T5) * 8); }
    else if (t < T7) {
      const float4* ps = (const float4*)(P.p + (long)li * S * 256) + (long)(t - T6) * 1024;
      uint2* pd = (uint2*)(P.ws + OFF_PBF) + (long)(t - T6) * 1024;
#pragma unroll
      for (int j = 0; j < 2; ++j) { const float4 v = ps[tid + NT * j]; uint2 o; o.x = pk2(v.x, v.y); o.y = pk2(v.z, v.w); pd[tid + NT * j] = o; }
    } else if (t < T8) {
      if (tid < 64) {
        float* sc = (float*)(P.ws + OFF_SC);
        const float mqa = wave_max(fabsf(P.a_q_norm[li * 64 + tid])), mka = wave_max(fabsf(P.a_k_norm[li * 64 + tid]));
        const float mqc = wave_max(fabsf(P.c_q_norm[li * 64 + tid])), mkc = wave_max(fabsf(P.c_k_norm[li * 64 + tid]));
        const float mqd = wave_max(fabsf(P.d_q_norm[li * 64 + tid])), mkd = wave_max(fabsf(P.d_k_norm[li * 64 + tid]));
        const float s1 = wave_sum(P.lq1[li * 64 + tid] * P.lk1[li * 64 + tid]);
        const float s2 = wave_sum(P.lq2[li * 64 + tid] * P.lk2[li * 64 + tid]);
        if (tid == 0) {
          sc[0] = 8.f * LOG2E * mqa * mka; sc[1] = 8.f * LOG2E * mqc * mkc; sc[2] = 8.f * LOG2E * mqd * mkd;
          const float lam_init = 0.8f - 0.6f * expf(-0.3f * (float)li);
          sc[3] = expf(s1) - expf(s2) + lam_init; sc[4] = lam_init;
        }
      }
    } else {
      float* c1 = (float*)(P.ws + OFF_COS1); float* s1 = (float*)(P.ws + OFF_SIN1);
      float* ax = (float*)(P.ws + OFF_AXT);
      const int b = t - T8;
      for (int idx = b * 2048 + tid; idx < (b + 1) * 2048; idx += NT) {
        const int tt = idx >> 3, i = idx & 7;
        float cs, sn; sincos_rev((double)tt * ROPE1_INV[i], cs, sn);
        c1[idx] = cs; s1[idx] = sn;
      }
      if (b == 0) {
        for (int idx = tid; idx < 256 * 16; idx += NT) {
          float cs, sn; sincos_rev((double)((idx >> 4) - 128) * AXIAL_INV[idx & 15], cs, sn);
          ax[idx] = cs; ax[4096 + idx] = sn;
        }
        for (int idx = tid; idx < 64 * 16; idx += NT) {
          float cs, sn; sincos_rev((double)((idx >> 4) - 32) * AXIAL_INV[idx & 15], cs, sn);
          ax[8192 + idx] = cs; ax[8192 + 1024 + idx] = sn;
        }
      }
    }
  }
}

DI void rows_bf16_store(char* smem, const float* v, bf16_t* dst0, long ld) {
  const int lane = tidx() & 63, r = lane & 31, h = lane >> 5;
  char* strip = smem + (tidx() >> 6) * (32 * 144);
#pragma unroll
  for (int q = 0; q < 4; ++q) *(uint4*)(strip + r * 144 + h * 64 + q * 16) = pack8(v + 8 * q);
#pragma unroll
  for (int j = 0; j < 4; ++j) {
    const int row = (lane >> 3) + 8 * j, ch = lane & 7;
    *(uint4*)(dst0 + (long)row * ld + ch * 8) = *(const uint4*)(strip + row * 144 + ch * 16);
  }
}

DI void rows_bf16_store_acc(char* smem, const f32x16& a0, const f32x16& a1, bf16_t* dst0, long ld) {
  const int lane = tidx() & 63, r = lane & 31, h = lane >> 5;
  char* strip = smem + (tidx() >> 6) * (32 * 144);
  *(bf16x8*)(strip + r * 144 + h * 64) = packP<0>(a0); *(bf16x8*)(strip + r * 144 + h * 64 + 16) = packP<1>(a0);
  *(bf16x8*)(strip + r * 144 + h * 64 + 32) = packP<0>(a1); *(bf16x8*)(strip + r * 144 + h * 64 + 48) = packP<1>(a1);
#pragma unroll
  for (int j = 0; j < 4; ++j) {
    const int row = (lane >> 3) + 8 * j, ch = lane & 7;
    *(uint4*)(dst0 + (long)row * ld + ch * 8) = *(const uint4*)(strip + row * 144 + ch * 16);
  }
}

template <int DIL>
DI void vt_store(char* smem, const f32x16 (&acc)[2][4], const float (&rin)[4], bf16_t* img  , int tbase) {
  const int lane = tidx() & 63, r = lane & 31, h = lane >> 5;
  bf16_t* strip = (bf16_t*)(smem + (tidx() >> 6) * 16384);
#pragma unroll
  for (int mt = 0; mt < 4; ++mt) {
    const int tl = mt * 32 + r, pp = (tl % DIL) * (128 / DIL) + tl / DIL;
#pragma unroll
    for (int tau = 0; tau < 2; ++tau)
#pragma unroll
      for (int i = 0; i < 16; ++i) strip[(32 * h + 16 * tau + i) * 128 + pp] = f2bf(acc[tau][mt][i] * rin[mt]);
  }
#pragma unroll 4
  for (int j = 0; j < 16; ++j) {
    const int c = lane + 64 * j, row = c >> 4, p0 = (c & 15) * 8;
    const int rho = p0 / (128 / DIL), o = p0 % (128 / DIL);
    *(uint4*)(img + (long)row * VTS + (long)rho * (S / DIL) + tbase / DIL + o) = *(const uint4*)(strip + row * 128 + p0);
  }
}

DI void inproj_epilogue(const Params& P, int li, f32x16 (&acc)[2][4], int mbase, int nbase, char* smem) {
  const int lane = tidx() & 63, r = lane & 31, h = lane >> 5;
  char* ws = P.ws;
  int kind; bf16_t* dst = nullptr; int ld = 0, col = 0; const float* nw = nullptr; float qs = 1.f;
  if (nbase < 512) { kind = 0; dst = (bf16_t*)(ws + OFF_QA); ld = LDQ; col = nbase; nw = P.a_q_norm + li * 64; qs = QSCALE; }
  else if (nbase < 1024) { kind = 0; dst = (bf16_t*)(ws + OFF_KA); ld = LDQ; col = nbase - 512; nw = P.a_k_norm + li * 64; }
  else if (nbase < 1536) { kind = 3; dst = (bf16_t*)(ws + OFF_VTA); col = nbase - 1024; }
  else if (nbase < 2048) { kind = 4; col = nbase - 1536; }
  else if (nbase < 2560) { kind = 5; col = nbase - 2048; }
  else if (nbase < 3072) { kind = 4; col = 512 + nbase - 2560; }
  else if (nbase < 3584) { kind = 1; dst = (bf16_t*)(ws + OFF_QC); ld = LDQ; col = nbase - 3072; nw = P.c_q_norm + li * 64; qs = QSCALE; }
  else if (nbase < 3712) { kind = 1; dst = (bf16_t*)(ws + OFF_KC); ld = 128; col = nbase - 3584; nw = P.c_k_norm + li * 64; }
  else if (nbase < 3840) { kind = 2; dst = (bf16_t*)(ws + OFF_VTC); col = nbase - 3712; }
  else if (nbase < 4352) { kind = 4; col = 1024 + nbase - 3840; }
  else if (nbase < 4864) { kind = 0; dst = (bf16_t*)(ws + OFF_QD); ld = LDQ; col = nbase - 4352; nw = P.d_q_norm + li * 64; qs = QSCALE; }
  else if (nbase < 5376) { kind = 0; dst = (bf16_t*)(ws + OFF_KD); ld = LDQ; col = nbase - 4864; nw = P.d_k_norm + li * 64; }
  else if (nbase < 5888) { kind = 2; dst = (bf16_t*)(ws + OFF_VTD); col = nbase - 5376; }
  else { kind = 4; col = 1536 + nbase - 5888; }

  if (kind == 2 || kind == 3) {
    float rinv4[4];
#pragma unroll
    for (int mt = 0; mt < 4; ++mt) rinv4[mt] = rsqrtf(((const float*)(ws + OFF_RS))[mbase + mt * 32 + r] * (1.f / DM) + 1e-6f);
    vt_store<1>(smem, acc, rinv4, dst + (long)col * VTS, mbase);
    if (kind == 3) {
      vt_store<4>(smem, acc, rinv4, dst + (long)(512 + col) * VTS, mbase);
      vt_store<16>(smem, acc, rinv4, dst + (long)(1024 + col) * VTS, mbase);
    }
    return;
  }
#pragma unroll
  for (int mt = 0; mt < 4; ++mt) {
    const int t = mbase + mt * 32 + r;
    float v[32];
    const float rin = rsqrtf(((const float*)(ws + OFF_RS))[t] * (1.f / DM) + 1e-6f);
#pragma unroll
    for (int i = 0; i < 16; ++i) { v[i] = acc[0][mt][i] * rin; v[16 + i] = acc[1][mt][i] * rin; }
    if (kind <= 1) {
      float ss = 0.f;
#pragma unroll
      for (int i = 0; i < 32; ++i) ss += v[i] * v[i];
      ss += __shfl_xor(ss, 32);
      const float rinv = rsqrtf(ss * (1.f / 64.f) + 1e-6f);
#pragma unroll
      for (int i = 0; i < 32; ++i) v[i] *= rinv * nw[32 * h + i];
      if (kind == 0) {
        if (h == 0) {
          const float* cs = (const float*)(ws + OFF_COS1) + (long)t * 8;
          const float* sn = (const float*)(ws + OFF_SIN1) + (long)t * 8;
#pragma unroll
          for (int i = 0; i < 8; ++i) {
            const float c = cs[i], s = sn[i], x1 = v[i], x2 = v[i + 8];
            v[i] = x1 * c - x2 * s; v[i + 8] = x1 * s + x2 * c;
          }
        }
      } else {
        const float* ax = (const float*)(ws + OFF_AXT);
        const float* cs = h == 0 ? ax + (t >> 6) * 16 : ax + 8192 + (t & 63) * 16;
        const float* sn = h == 0 ? ax + 4096 + (t >> 6) * 16 : ax + 8192 + 1024 + (t & 63) * 16;
#pragma unroll
        for (int i = 0; i < 16; ++i) {
          const float c = cs[i], s = sn[i], x1 = v[i], x2 = v[i + 16];
          v[i] = x1 * c - x2 * s; v[i + 16] = x1 * s + x2 * c;
        }
      }
#pragma unroll
      for (int i = 0; i < 32; ++i) v[i] *= qs;
      rows_bf16_store(smem, v, dst + (long)(mbase + mt * 32) * ld + col, ld);
    } else if (kind == 4) {
#pragma unroll
      for (int i = 0; i < 32; ++i) v[i] = siluf_(v[i]);
      rows_bf16_store(smem, v, (bf16_t*)(ws + OFF_GATE) + (long)(mbase + mt * 32) * LDH + col, LDH);
    } else {
      rows_bf16_store(smem, v, (bf16_t*)(ws + OFF_U) + (long)(mbase + mt * 32) * LDQ + col, LDQ);
    }
  }
}

DI void pe_tile(const Params& P, int tt, char* smem) {
  const int lane = tidx() & 63, w = tidx() >> 6, wn = w & 3, wm = w >> 2, r = lane & 31, h = lane >> 5;
  const int nt = tt >> 6, mt = tt & 63;
  f32x16 acc[2][4]; zero_acc(acc);
  GemmSeg sg{(const bf16_t*)(P.ws + OFF_PBF), 256, 16, (const bf16_t*)(P.ws + OFF_WTPLE), 256, 256};
  gemm_kloop(acc, sg, mt * 256, nt * 256, smem);
  bf16_t* pe = (bf16_t*)(P.ws + OFF_PE);
#pragma unroll
  for (int m4 = 0; m4 < 4; ++m4) {
    char* strip = smem + w * (32 * 144);
    *(bf16x8*)(strip + r * 144 + h * 64) = packP<0>(acc[0][m4]); *(bf16x8*)(strip + r * 144 + h * 64 + 16) = packP<1>(acc[0][m4]);
    *(bf16x8*)(strip + r * 144 + h * 64 + 32) = packP<0>(acc[1][m4]); *(bf16x8*)(strip + r * 144 + h * 64 + 48) = packP<1>(acc[1][m4]);
    bf16_t* dst0 = pe + (long)(mt * 256 + wm * 128 + m4 * 32) * DM + nt * 256 + wn * 64;
#pragma unroll
    for (int j = 0; j < 4; ++j) {
      const int row = (lane >> 3) + 8 * j, ch = lane & 7;
      *(uint4*)(dst0 + (long)row * DM + ch * 8) = *(const uint4*)(strip + row * 144 + ch * 16);
    }
  }
}

DI void phase2(const Params& P, int li, char* smem) {
  const int w = tidx() >> 6, wn = w & 3, wm = w >> 2;
  for (int t = blockIdx.x; t < 64 * 25; t += gridDim.x) {
    const int nt = t >> 6, mt = t & 63;
    f32x16 acc[2][4]; zero_acc(acc);
    GemmSeg sg{(const bf16_t*)(P.ws + OFF_H), LDH, 16, (const bf16_t*)(P.ws + OFF_WTIN), LDH, DM};
    gemm_kloop(acc, sg, mt * 256, nt * 256, smem);
    inproj_epilogue(P, li, acc, mt * 256 + wm * 128, nt * 256 + wn * 64, smem);
  }
  const int b0 = gridDim.x == 256 ? 64 : 0, nb = gridDim.x - b0;
  if ((int)blockIdx.x >= b0) {
    for (int pt = blockIdx.x - b0; pt < 512; pt += nb) pe_tile(P, pt, smem);
    if (li + 1 < NLAYER) {
      const int ln = li + 1;
      bf16_t* wo = (bf16_t*)(P.ws + ((ln & 1) ? OFF_WTOUT2 : OFF_WTOUT));
      bf16_t* wg = (bf16_t*)(P.ws + ((ln & 1) ? OFF_WTGATE2 : OFF_WTGATE));
      for (int tt = blockIdx.x - b0; tt < 2048; tt += nb) {
        if (tt < 1024) transpose_task(P.w_out + (long)ln * DM * DM, DM, LDH, wo, tt, 32, false, smem);
        else transpose_task(P.ple_gate_w + (long)ln * DM * DM, DM, LDH, wg, tt - 1024, 32, false, smem, P.ple_norm_w + ln * DM);
      }
    }
  }
}


constexpr int EPI_PITCH = 68;
DI float* epi_strip(char* smem) { return (float*)smem + (tidx() >> 6) * (32 * EPI_PITCH); }
DI void epi_park(float* strip, const f32x16& a0, const f32x16& a1) {
  const int lane = tidx() & 63, r = lane & 31, h = lane >> 5;
  float* d = strip + r * EPI_PITCH + 32 * h;
#pragma unroll
  for (int q = 0; q < 4; ++q) {
    *(float4*)(d + 4 * q) = make_float4(a0[4 * q], a0[4 * q + 1], a0[4 * q + 2], a0[4 * q + 3]);
    *(float4*)(d + 16 + 4 * q) = make_float4(a1[4 * q], a1[4 * q + 1], a1[4 * q + 2], a1[4 * q + 3]);
  }
}

DI void epi_park_o(float* strip, const f32x16& o0, const f32x16& o1, float sc) {
  const int lane = tidx() & 63, r = lane & 31, h = lane >> 5;
  float* d = strip + r * EPI_PITCH + 16 * h;
#pragma unroll
  for (int q = 0; q < 4; ++q) {
    *(float4*)(d + 4 * q) = make_float4(o0[4 * q] * sc, o0[4 * q + 1] * sc, o0[4 * q + 2] * sc, o0[4 * q + 3] * sc);
    *(float4*)(d + 32 + 4 * q) = make_float4(o1[4 * q] * sc, o1[4 * q + 1] * sc, o1[4 * q + 2] * sc, o1[4 * q + 3] * sc);
  }
}

template <int QT, int DT, bool SHIFT>
DI void flash_run(f32x16 (&O)[QT][DT], float (&ls)[QT], const bf16_t* Qp, int ldq, const bf16_t* Kp, int ldk, const bf16_t* Vtp,
                  float negc, char* smem) {
  constexpr int STG = 9216 + DT * 32 * 144;
  const int tid = tidx(), lane = tid & 63, w = tid >> 6, r = lane & 31, h = lane >> 5;
  bf16x8 qf[QT][4];
#pragma unroll
  for (int qt = 0; qt < QT; ++qt)
#pragma unroll
    for (int kk = 0; kk < 4; ++kk) qf[qt][kk] = ld_frag(Qp + (long)(w * (32 * QT) + qt * 32 + r) * ldq + kk * 16 + 8 * h);
#pragma unroll
  for (int qt = 0; qt < QT; ++qt) {
    ls[qt] = 0.f;
#pragma unroll
    for (int dt = 0; dt < DT; ++dt) O[qt][dt] = splat16(0.f);
  }
  u32x4 sk[1], sv[DT / 2];
  const int srow = tid >> 3, skc = tid & 7;
  const bf16_t* ksrc = Kp + (long)srow * ldk + skc * 8;
  const bf16_t* vsrc = Vtp + (long)srow * VTS + skc * 8;
  const int slo = srow * 144 + skc * 16;
  const int koff = kperm(r) * 144 + h * 16;
  const int voff = 9216 + aperm(r) * 144 + h * 16;
  sk[0] = *(const u32x4*)(ksrc);
#pragma unroll
  for (int j = 0; j < DT / 2; ++j) sv[j] = *(const u32x4*)(vsrc + (long)(64 * j) * VTS);
  __syncthreads();
  *(u32x4*)(smem + slo) = sk[0];
#pragma unroll
  for (int j = 0; j < DT / 2; ++j) *(u32x4*)(smem + 9216 + slo + j * 64 * 144) = sv[j];
  sk[0] = *(const u32x4*)(ksrc + (long)64 * ldk);
#pragma unroll
  for (int j = 0; j < DT / 2; ++j) sv[j] = *(const u32x4*)(vsrc + (long)(64 * j) * VTS + 64);
  __syncthreads();
  constexpr int NKT = S / 64;
  for (int kt = 0; kt < NKT; ++kt) {
    char* db = smem + ((kt + 1) & 1) * STG;
    const int key0 = (kt + 2 < NKT ? kt + 2 : NKT - 1) * 64;
    const char* sb = smem + (kt & 1) * STG;
#pragma unroll
    for (int ksub = 0; ksub < 2; ++ksub) {
      bf16x8 kf[4], vf[DT][2];
#pragma unroll
      for (int kk = 0; kk < 4; ++kk) kf[kk] = ld_frag(sb + koff + ksub * 32 * 144 + kk * 32);
#pragma unroll
      for (int dt = 0; dt < DT; ++dt)
#pragma unroll
        for (int s2 = 0; s2 < 2; ++s2) vf[dt][s2] = ld_frag(sb + voff + dt * 32 * 144 + (ksub * 32 + 16 * s2) * 2);
      __builtin_amdgcn_sched_barrier(0);
      bf16x8 pf[QT][2];
#pragma unroll
      for (int qt = 0; qt < QT; ++qt) {
        f32x16 sx = splat16(SHIFT ? negc : 0.f);
#pragma unroll
        for (int kk = 0; kk < 4; ++kk) sx = mfma(kf[kk], qf[qt][kk], sx);
        float lsum = 0.f;
#pragma unroll
        for (int e = 0; e < 16; ++e) { sx[e] = __builtin_amdgcn_exp2f(sx[e]); lsum += sx[e]; }
        ls[qt] += lsum;
        pf[qt][0] = packP<0>(sx); pf[qt][1] = packP<1>(sx);
      }
      if (ksub == 0) {
        *(u32x4*)(db + slo) = sk[0];
        sk[0] = *(const u32x4*)(ksrc + (long)key0 * ldk);
      } else {
#pragma unroll
        for (int j = 0; j < DT / 2; ++j) *(u32x4*)(db + 9216 + slo + j * 64 * 144) = sv[j];
#pragma unroll
        for (int j = 0; j < DT / 2; ++j) sv[j] = *(const u32x4*)(vsrc + (long)(64 * j) * VTS + key0);
      }
#pragma unroll
      for (int dt = 0; dt < DT; ++dt)
#pragma unroll
        for (int s2 = 0; s2 < 2; ++s2)
#pragma unroll
          for (int qt = 0; qt < QT; ++qt) O[qt][dt] = mfma(vf[dt][s2], pf[qt][s2], O[qt][dt]);
    }
    __syncthreads();
  }
}

DI void attn_c_task(const Params& P, int task, char* smem) {
  const int hq = task >> 5, qb = task & 31, q0 = qb * 512;
  const int lane = tidx() & 63, w = tidx() >> 6, r = lane & 31, h = lane >> 5;
  const float negc = -((const float*)(P.ws + OFF_SC))[1];
  f32x16 O[2][2]; float ls[2];
  const bf16_t* Qp = (const bf16_t*)(P.ws + OFF_QC) + (long)q0 * LDQ + hq * 64;
  const bf16_t* Kp = (const bf16_t*)(P.ws + OFF_KC) + (hq >> 2) * 64;
  const bf16_t* Vp = (const bf16_t*)(P.ws + OFF_VTC) + (long)((hq >> 2) * 64) * VTS;
  if (negc < -64.f) flash_run<2, 2, true>(O, ls, Qp, LDQ, Kp, 128, Vp, negc, smem);
  else flash_run<2, 2, false>(O, ls, Qp, LDQ, Kp, 128, Vp, negc, smem);
  const bf16_t* gate = (const bf16_t*)(P.ws + OFF_GATE);
  bf16_t* mixed = (bf16_t*)(P.ws + OFF_MIXED);
#pragma unroll
  for (int qt = 0; qt < 2; ++qt) {
    const float l = ls[qt] + __shfl_xor(ls[qt], 32);
    const float inv = 1.f / l;
    const int t = q0 + w * 64 + qt * 32 + r;
#pragma unroll
    for (int dt = 0; dt < 2; ++dt) {
      const long off = (long)t * LDH + 1024 + hq * 64 + dt * 32 + 16 * h;
      float g[16], v[16];
      unpack8(*(const uint4*)(gate + off), g); unpack8(*(const uint4*)(gate + off + 8), g + 8);
#pragma unroll
      for (int i = 0; i < 16; ++i) v[i] = O[qt][dt][i] * inv * g[i];
      *(uint4*)(mixed + off) = pack8(v); *(uint4*)(mixed + off + 8) = pack8(v + 8);
    }
  }
}

DI void attn_d_task(const Params& P, int task, char* smem) {
  const int inst = task >> 6, qb = task & 63, q0 = qb * 256, hh = inst >> 1, c = inst & 1;
  const int lane = tidx() & 63, w = tidx() >> 6, r = lane & 31, h = lane >> 5;
  const float negc = -((const float*)(P.ws + OFF_SC))[2];
  f32x16 O[1][4]; float ls[1];
  const bf16_t* Qp = (const bf16_t*)(P.ws + OFF_QD) + (long)q0 * LDQ + inst * 64;
  const bf16_t* Kp = (const bf16_t*)(P.ws + OFF_KD) + inst * 64;
  const bf16_t* Vp = (const bf16_t*)(P.ws + OFF_VTD) + (long)(hh * 128) * VTS;
  if (negc < -64.f) flash_run<1, 4, true>(O, ls, Qp, LDQ, Kp, LDQ, Vp, negc, smem);
  else flash_run<1, 4, false>(O, ls, Qp, LDQ, Kp, LDQ, Vp, negc, smem);
  float* dtmp = (float*)(P.ws + OFF_DTMP) + (long)c * S * 512;
  {
    const float l = ls[0] + __shfl_xor(ls[0], 32);
    const float inv = 1.f / l;
    float* strip = epi_strip(smem);
#pragma unroll
    for (int half = 0; half < 2; ++half) {
      epi_park_o(strip, O[0][2 * half], O[0][2 * half + 1], inv);
#pragma unroll 4
      for (int j = 0; j < 8; ++j) {
        const int row = 4 * j + (lane >> 4), c4 = (lane & 15) * 4;
        const int t = q0 + w * 32 + row;
        *(float4*)(dtmp + (long)t * 512 + hh * 128 + half * 64 + c4) = *(const float4*)(strip + row * EPI_PITCH + c4);
      }
    }
  }
}

template <int DIL, int NSUB>
DI void band_pattern(f32x16 (&O)[2], float& lsum, const bf16x8 (&qf)[4], const bf16_t* Kp  , const bf16_t* Vt  ,
                     int rho, int mstart, int mq, float negc, char* strip) {
  constexpr int ND = S / DIL;
  const int lane = tidx() & 63, r = lane & 31, h = lane >> 5;
  const int krow = lane >> 3, kch = lane & 7, vrow = lane >> 2, vch = lane & 3;
  char* Ks = strip; char* Vs = strip + 32 * 144;
  u32x4 kreg[4], vreg[4];
#define BP_FETCH(SUB) { const int ms_ = mstart + 32 * (SUB); \
    _Pragma("unroll") for (int j = 0; j < 4; ++j) { \
      int m_ = ms_ + krow + 8 * j; m_ = m_ < 0 ? 0 : (m_ > ND - 1 ? ND - 1 : m_); \
      kreg[j] = *(const u32x4*)(Kp + (long)(rho + DIL * m_) * LDQ + kch * 8); } \
    int mc_ = ms_ + vch * 8; mc_ = mc_ < 0 ? 0 : (mc_ > ND - 8 ? ND - 8 : mc_); \
    _Pragma("unroll") for (int j = 0; j < 4; ++j) vreg[j] = *(const u32x4*)(Vt + (long)(vrow + 16 * j) * VTS + rho * ND + mc_); }
  BP_FETCH(0)
  const int koff = kperm(r) * 144 + h * 16, voff = aperm(r) * 80 + h * 16;
  for (int sub = 0; sub < NSUB; ++sub) {
    const int ms = mstart + 32 * sub;
#pragma unroll
    for (int j = 0; j < 4; ++j) *(u32x4*)(Ks + (krow + 8 * j) * 144 + kch * 16) = kreg[j];
#pragma unroll
    for (int j = 0; j < 4; ++j) *(u32x4*)(Vs + (vrow + 16 * j) * 80 + vch * 16) = vreg[j];
    { const int ns = sub + 1 < NSUB ? sub + 1 : NSUB - 1; BP_FETCH(ns) }
    bf16x8 kf[4], vf[2][2];
#pragma unroll
    for (int kk = 0; kk < 4; ++kk) kf[kk] = ld_frag(Ks + koff + kk * 32);
#pragma unroll
    for (int dt = 0; dt < 2; ++dt)
#pragma unroll
      for (int s2 = 0; s2 < 2; ++s2) vf[dt][s2] = ld_frag(Vs + voff + dt * 32 * 80 + s2 * 32);
    f32x16 sx = splat16(negc);
#pragma unroll
    for (int kk = 0; kk < 4; ++kk) sx = mfma(kf[kk], qf[kk], sx);
#pragma unroll
    for (int e = 0; e < 16; ++e) {
      const int me = ms + 16 * (e >> 3) + 8 * h + (e & 7);
      const int dd = me - mq;
      const bool valid = (dd <= 64) && (dd >= -64) && (me >= 0) && (me < ND);
      sx[e] = valid ? __builtin_amdgcn_exp2f(sx[e]) : 0.f;
      lsum += sx[e];
    }
    bf16x8 pf[2];
    pf[0] = packP<0>(sx); pf[1] = packP<1>(sx);
#pragma unroll
    for (int s2 = 0; s2 < 2; ++s2)
#pragma unroll
      for (int dt = 0; dt < 2; ++dt) O[dt] = mfma(vf[dt][s2], pf[s2], O[dt]);
  }
#undef BP_FETCH
}

template <int DIL, int PASS>
DI void attn_a_pass(const Params& P, int wt, char* smem) {
  const int lane = tidx() & 63, r = lane & 31, h = lane >> 5;
  const int head = wt >> 9, rem = wt & 511, rho = rem & (DIL - 1), b = rem / DIL;
  const float negc = -((const float*)(P.ws + OFF_SC))[0];
  const int mq = 32 * b + r, pos = rho + DIL * mq;
  const bf16_t* qa = (const bf16_t*)(P.ws + OFF_QA) + (long)pos * LDQ + head * 64 + 8 * h;
  bf16x8 qf[4];
#pragma unroll
  for (int kk = 0; kk < 4; ++kk) qf[kk] = ld_frag(qa + kk * 16);
  const bf16_t* Kp = (const bf16_t*)(P.ws + OFF_KA) + head * 64;
  const bf16_t* Vt = (const bf16_t*)(P.ws + OFF_VTA) + (long)(DIL == 1 ? 0 : (DIL == 4 ? 512 : 1024)) * VTS + (long)(head * 64) * VTS;
  f32x16 O[2]; O[0] = splat16(0.f); O[1] = splat16(0.f);
  float lsum = 0.f;
  band_pattern<DIL, 5>(O, lsum, qf, Kp, Vt, rho, 32 * b - 64, mq, negc, smem + (tidx() >> 6) * 9728);
  float l = lsum + __shfl_xor(lsum, 32);
  float* ol = (float*)(P.ws + OFF_AOL) + (long)pos * 8 + head;
  if (PASS > 0) l += *ol;
  if (PASS < 2 && h == 0) *ol = l;
  float* strip = (float*)(smem + (tidx() >> 6) * 9728);
  epi_park_o(strip, O[0], O[1], 1.f);
  const bf16_t* gate = (const bf16_t*)(P.ws + OFF_GATE);
  bf16_t* mixed = (bf16_t*)(P.ws + OFF_MIXED);
#pragma unroll 4
  for (int j = 0; j < 8; ++j) {
    const int row = 4 * j + (lane >> 4), c4 = (lane & 15) * 4;
    const int prow = rho + DIL * (32 * b + row);
    float4 a = *(const float4*)(strip + row * EPI_PITCH + c4);
    float* oa = (float*)(P.ws + OFF_AOA) + ((long)prow * 8 + head) * 64 + c4;
    if (PASS > 0) { const float4 pv = *(const float4*)oa; a.x += pv.x; a.y += pv.y; a.z += pv.z; a.w += pv.w; }
    if (PASS < 2) *(float4*)oa = a;
    else {
      const float inv = 1.f / __shfl(l, row);
      const long off = (long)prow * LDH + head * 64 + c4;
      const uint2 gu = *(const uint2*)(gate + off);
      uint2 o;
      o.x = pk2(a.x * inv * __uint_as_float(gu.x << 16), a.y * inv * __uint_as_float(gu.x & 0xffff0000u));
      o.y = pk2(a.z * inv * __uint_as_float(gu.y << 16), a.w * inv * __uint_as_float(gu.y & 0xffff0000u));
      *(uint2*)(mixed + off) = o;
    }
  }
}

DI void s5local_task(const Params& P, int task, char* smem) {
  const int g = task >> 1, mt = task & 1, nt = 0;
  const int lane = tidx() & 63, w = tidx() >> 6, wn = w & 3, wm = w >> 2, r = lane & 31, h = lane >> 5;
  f32x16 acc[2][4]; zero_acc(acc);
  GemmSeg sg{(const bf16_t*)(P.ws + OFF_U) + g * 16, 32 * LDQ, LDQ, (const bf16_t*)(P.ws + OFF_W1) + (long)g * 256 * LDQ, LDQ, 512};
  gemm_kloop(acc, sg, mt * 256, nt * 256, smem);
  float* xl = (float*)(P.ws + OFF_XLOC) + (long)g * 512 * 256;
#pragma unroll
  for (int m4 = 0; m4 < 4; ++m4) {
    const int chunk = mt * 256 + wm * 128 + m4 * 32 + r;
#pragma unroll
    for (int tau = 0; tau < 2; ++tau) {
      float* d = xl + (long)chunk * 256 + nt * 256 + wn * 64 + 32 * h + 16 * tau;
#pragma unroll
      for (int q = 0; q < 4; ++q)
        *(float4*)(d + 4 * q) = make_float4(acc[tau][m4][4 * q], acc[tau][m4][4 * q + 1], acc[tau][m4][4 * q + 2], acc[tau][m4][4 * q + 3]);
    }
  }
}

DI void phase3(const Params& P, char* smem) {
  constexpr int T0 = 512, T1 = T0 + 256, T2 = T1 + 64, T3 = T2 + 512;
  for (int t = blockIdx.x; t < T3; t += gridDim.x) {
    if (t < T0) attn_d_task(P, t, smem);
    else if (t < T1) attn_c_task(P, t - T0, smem);
    else if (t < T2) s5local_task(P, t - T1, smem);
    else attn_a_pass<16, 0>(P, (t - T2) * 8 + (tidx() >> 6), smem);
  }
}

DI void phase4(const Params& P, int li, char* smem) {
  const int lane = tidx() & 63, w = tidx() >> 6;
  const int nw = gridDim.x * 8, gw = blockIdx.x * 8 + w;
  const float* sc = (const float*)(P.ws + OFF_SC);
  const float lam = sc[3], lam_init = sc[4];
  for (int i = blockIdx.x * NT + tidx(); i < 2 * S; i += gridDim.x * NT) ((float*)(P.ws + OFF_RS))[i] = 0.f;
  for (int t = gw; t < 64 + S * 4 + 4096; t += nw) {
    if (t >= 64 + S * 4) {
      attn_a_pass<4, 1>(P, t - (64 + S * 4), smem);
    } else if (t < 64) {
      const int g = t >> 1, dir = t & 1;
      const float2 AT = ((const float2*)(P.ws + OFF_APT))[(dir * 32 + g) * 64 + lane];
      const float* xl = (const float*)(P.ws + OFF_XLOC) + (long)g * 512 * 256 + dir * 128 + lane;
      bf16_t* ci = (bf16_t*)(P.ws + OFF_CIN) + (long)g * 512 * 256 + dir * 128 + lane;
      float xr = 0.f, xi = 0.f;
      for (int s0 = 0; s0 < 512; s0 += 16) {
        float lr[16], lm[16];
#pragma unroll
        for (int u = 0; u < 16; ++u) {
          const int chunk = dir ? 511 - (s0 + u) : s0 + u;
          lr[u] = xl[chunk * 256]; lm[u] = xl[chunk * 256 + 64];
        }
#pragma unroll
        for (int u = 0; u < 16; ++u) {
          const int chunk = dir ? 511 - (s0 + u) : s0 + u;
          ci[chunk * 256] = f2bf(xr); ci[chunk * 256 + 64] = f2bf(xi);
          const float nr = AT.x * xr - AT.y * xi + lr[u], ni = AT.x * xi + AT.y * xr + lm[u];
          xr = nr; xi = ni;
        }
      }
    } else {
      const int tt = (t - 64) >> 2, hh = (t - 64) & 3;
      const long off = (long)tt * 512 + hh * 128 + 2 * lane;
      const float2 o1 = *(const float2*)((const float*)(P.ws + OFF_DTMP) + off);
      const float2 o2 = *(const float2*)((const float*)(P.ws + OFF_DTMP) + (long)S * 512 + off);
      const float a = o1.x - lam * o2.x, b = o1.y - lam * o2.y;
      const float ss = wave_sum(a * a + b * b);
      const float rinv = rsqrtf(ss * (1.f / 128.f) + 1e-6f) * (1.f - lam_init);
      const float2 sw = *(const float2*)(P.d_subln + li * 128 + 2 * lane);
      const long mo = (long)tt * LDH + 1536 + hh * 128 + 2 * lane;
      const unsigned gg = *(const unsigned*)((const bf16_t*)(P.ws + OFF_GATE) + mo);
      const float g0 = __uint_as_float(gg << 16), g1 = __uint_as_float(gg & 0xffff0000u);
      *(unsigned*)((bf16_t*)(P.ws + OFF_MIXED) + mo) = pk2(a * rinv * sw.x * g0, b * rinv * sw.y * g1);
    }
  }
}

DI float gelu_tanh(float y) {
  const float u = 0.7978845608028654f * (y + 0.044715f * y * y * y);
  const float e = __expf(2.f * u);
  const float th = 1.f - 2.f / (e + 1.f);
  return 0.5f * y * (1.f + th);
}

DI void phase5(const Params& P, char* smem) {
  const int lane = tidx() & 63, w = tidx() >> 6, wn = w & 3, wm = w >> 2, r = lane & 31, h = lane >> 5;
  if (gridDim.x == 256 && blockIdx.x >= 128) {
    for (int a = blockIdx.x - 128; a < 512; a += 128) attn_a_pass<1, 2>(P, a * 8 + w, smem);
    return;
  }
  for (int t = blockIdx.x; t < (gridDim.x == 256 ? 128 : 128 + 512); t += gridDim.x) {
    if (t >= 128) { attn_a_pass<1, 2>(P, (t - 128) * 8 + w, smem); continue; }
    const int g = t >> 2, mt = (t >> 1) & 1, nt = t & 1;
    f32x16 acc[2][4]; zero_acc(acc);
    const bf16_t* W3 = (const bf16_t*)(P.ws + OFF_W3) + (long)g * 512 * 1280;
    const bf16_t* U = (const bf16_t*)(P.ws + OFF_U) + g * 16;
    GemmSeg s0{U, 32 * LDQ, LDQ, W3, 1280, 512};
    gemm_kloop(acc, s0, mt * 256, nt * 256, smem);
    GemmSeg s1{U, 32 * LDQ, LDQ, W3 + 512, 1280, 512};
    gemm_kloop(acc, s1, mt * 256, nt * 256, smem);
    GemmSeg s2{(const bf16_t*)(P.ws + OFF_CIN) + (long)g * 512 * 256, 256, 16, W3 + 1024, 1280, 256};
    gemm_kloop(acc, s2, mt * 256, nt * 256, smem);
    bf16_t* yb = (bf16_t*)(P.ws + OFF_Y);
#pragma unroll
    for (int m4 = 0; m4 < 4; ++m4) {
      const int chunk = mt * 256 + wm * 128 + m4 * 32 + r;
#pragma unroll
      for (int tau = 0; tau < 2; ++tau) {
        const int n = nt * 256 + wn * 64 + 32 * h + 16 * tau;
        const int jo = n >> 4;
        float v[16];
#pragma unroll
        for (int i = 0; i < 16; ++i) v[i] = gelu_tanh(acc[tau][m4][i]);
        bf16_t* d = yb + (long)(chunk * 32 + jo) * LDQ + g * 16;
        *(uint4*)d = pack8(v); *(uint4*)(d + 8) = pack8(v + 8);
      }
    }
  }
}

DI void phase6(const Params& P, int li, char* smem) {
  const int lane = tidx() & 63, w = tidx() >> 6, wn = w & 3, wm = w >> 2, r = lane & 31, h = lane >> 5;
  for (int t = blockIdx.x; t < 64 * 4; t += gridDim.x) {
    const int nt = t >> 6, mt = t & 63;
    f32x16 acc[2][4]; zero_acc(acc);
    GemmSeg sg{(const bf16_t*)(P.ws + OFF_Y), LDQ, 16, (const bf16_t*)(P.ws + OFF_WTGLU), LDQ, 512};
    gemm_kloop(acc, sg, mt * 256, nt * 256, smem);
    const int colb = ((nt * 256 + wn * 64 + 32 * h) >> 5) * 16;
    const float* bg = P.b_glu + li * 1024;
    const bf16_t* gate = (const bf16_t*)(P.ws + OFF_GATE);
    bf16_t* mixed = (bf16_t*)(P.ws + OFF_MIXED);
#pragma unroll
    for (int m4 = 0; m4 < 4; ++m4) {
      const int tok = mt * 256 + wm * 128 + m4 * 32 + r;
      const long off = (long)tok * LDH + 512 + colb;
      float g[16], v[16];
      unpack8(*(const uint4*)(gate + off), g); unpack8(*(const uint4*)(gate + off + 8), g + 8);
#pragma unroll
      for (int i = 0; i < 16; ++i) {
        const float z1 = acc[0][m4][i] + bg[colb + i], z2 = acc[1][m4][i] + bg[512 + colb + i];
        v[i] = z1 * sigmoidf_(z2) * g[i];
      }
      *(uint4*)(mixed + off) = pack8(v); *(uint4*)(mixed + off + 8) = pack8(v + 8);
    }
  }
}

DI void phase7(const Params& P, int li, char* smem) {
  const int lane = tidx() & 63, w = tidx() >> 6, wn = w & 3, wm = w >> 2, r = lane & 31, h = lane >> 5;
  const float* xs = li == 0 ? P.x : P.out;
  for (int t = blockIdx.x; t < 512; t += gridDim.x) {
    const int tt = t & 511, nt = tt >> 6, mt = tt & 63;
    f32x16 acc[2][4]; zero_acc(acc);
    {
      GemmSeg sg{(const bf16_t*)(P.ws + OFF_MIXED), LDH, 16, (const bf16_t*)(P.ws + ((li & 1) ? OFF_WTOUT2 : OFF_WTOUT)), LDH, DM};
      gemm_kloop(acc, sg, mt * 256, nt * 256, smem);
      float* strip = epi_strip(smem);
#pragma unroll
      for (int m4 = 0; m4 < 4; ++m4) {
        epi_park(strip, acc[0][m4], acc[1][m4]);
#pragma unroll 2
        for (int j = 0; j < 8; ++j) {
          const int row = 4 * j + (lane >> 4), c4 = (lane & 15) * 4;
          const int tok = mt * 256 + wm * 128 + m4 * 32 + row;
          const float4 a = *(const float4*)(strip + row * EPI_PITCH + c4);
          const long off = (long)tok * DM + nt * 256 + wn * 64 + c4;
          const float4 xv = *(const float4*)(xs + off);
          const float4 xn = make_float4(xv.x + a.x, xv.y + a.y, xv.z + a.z, xv.w + a.w);
          *(float4*)(P.out + off) = xn;
          uint2 hb2; hb2.x = pk2(xn.x, xn.y); hb2.y = pk2(xn.z, xn.w);
          *(uint2*)((bf16_t*)(P.ws + OFF_H2) + (long)tok * LDH + nt * 256 + wn * 64 + c4) = hb2;
          float ssq = xn.x * xn.x + xn.y * xn.y + xn.z * xn.z + xn.w * xn.w;
          ssq += __shfl_xor(ssq, 1); ssq += __shfl_xor(ssq, 2); ssq += __shfl_xor(ssq, 4); ssq += __shfl_xor(ssq, 8);
          if ((lane & 15) == 0) atomicAdd((float*)(P.ws + OFF_RS) + S + tok, ssq);
        }
      }
    }
  }
}

DI void phase9(const Params& P, int li, char* smem) {
  const int lane = tidx() & 63, w = tidx() >> 6, wn = w & 3, wm = w >> 2, r = lane & 31, h = lane >> 5;
  for (int t = blockIdx.x; t < 512; t += gridDim.x) {
    const int nt = t >> 6, mt = t & 63;
    f32x16 acc[2][4]; zero_acc(acc);
    GemmSeg sg{(const bf16_t*)(P.ws + OFF_H2), LDH, 16, (const bf16_t*)(P.ws + ((li & 1) ? OFF_WTGATE2 : OFF_WTGATE)), LDH, DM};
    gemm_kloop(acc, sg, mt * 256, nt * 256, smem);
    const bf16_t* pe = (const bf16_t*)(P.ws + OFF_PE);
    float* strip = epi_strip(smem);
#pragma unroll
    for (int m4 = 0; m4 < 4; ++m4) {
      epi_park(strip, acc[0][m4], acc[1][m4]);
#pragma unroll 2
      for (int j = 0; j < 8; ++j) {
        const int row = 4 * j + (lane >> 4), c4 = (lane & 15) * 4;
        const int tok = mt * 256 + wm * 128 + m4 * 32 + row;
        const float rin = rsqrtf(((const float*)(P.ws + OFF_RS))[S + tok] * (1.f / DM) + 1e-6f);
        const float4 a = *(const float4*)(strip + row * EPI_PITCH + c4);
        const long off = (long)tok * DM + nt * 256 + wn * 64 + c4;
        const float4 xv = *(const float4*)(P.out + off);
        const uint2 pu = *(const uint2*)(pe + off);
        const float e0 = __uint_as_float(pu.x << 16), e1 = __uint_as_float(pu.x & 0xffff0000u);
        const float e2 = __uint_as_float(pu.y << 16), e3 = __uint_as_float(pu.y & 0xffff0000u);
        const float4 xn = make_float4(xv.x + sigmoidf_(a.x * rin) * e0, xv.y + sigmoidf_(a.y * rin) * e1,
                                      xv.z + sigmoidf_(a.z * rin) * e2, xv.w + sigmoidf_(a.w * rin) * e3);
        *(float4*)(P.out + off) = xn;
        uint2 hb2; hb2.x = pk2(xn.x, xn.y); hb2.y = pk2(xn.z, xn.w);
        *(uint2*)((bf16_t*)(P.ws + OFF_H) + (long)tok * LDH + nt * 256 + wn * 64 + c4) = hb2;
        float ssq = xn.x * xn.x + xn.y * xn.y + xn.z * xn.z + xn.w * xn.w;
        ssq += __shfl_xor(ssq, 1); ssq += __shfl_xor(ssq, 2); ssq += __shfl_xor(ssq, 4); ssq += __shfl_xor(ssq, 8);
        if ((lane & 15) == 0) atomicAdd((float*)(P.ws + OFF_RS) + tok, ssq);
      }
    }
  }
}

#define XB_TMO      128
#define XB_XCNT(j)  (256  + 64 * (j))
#define XB_XSUB(j)  (1280 + 64 * (j))
#define XB_XGEN(j)  (2304 + 64 * (j))
#define XB_TOP      3328
#define XB_TOPGEN   3392
#define XCD_BAR_WORDS 3456
#define XB_SPIN_CAP (1u << 20)
#define LAS __attribute__((address_space(3)))
DI unsigned xb_ld(unsigned* p) { return __hip_atomic_load(p, __ATOMIC_RELAXED, __HIP_MEMORY_SCOPE_AGENT); }
DI unsigned xb_add(unsigned* p, unsigned v) { return __hip_atomic_fetch_add(p, v, __ATOMIC_RELAXED, __HIP_MEMORY_SCOPE_AGENT); }
DI unsigned xb_xcc_id() { return (unsigned)__builtin_amdgcn_s_getreg((3 << 11) | 20) & 0xFu; }
#define XB_SPIN(cond, bar) do { unsigned _sp = 0; while (cond) { __builtin_amdgcn_s_sleep(1); \
    if ((++_sp & 255u) == 0u) { if (xb_ld(&(bar)[XB_TMO])) break; if (_sp > XB_SPIN_CAP) { atomicAdd(&(bar)[XB_TMO], 1u); break; } } } } while (0)
struct XcdBarrier { unsigned* bar; unsigned x; volatile LAS unsigned* st; };
DI XcdBarrier xcd_barrier_post(unsigned* bar, volatile LAS unsigned* st) {
  XcdBarrier b; b.bar = bar; b.x = xb_xcc_id(); b.st = st;
  if (threadIdx.x == 0) (void)xb_add(&bar[XB_XCNT(b.x)], 1u);
  return b;
}
DI void xcd_barrier_complete(unsigned* bar, unsigned x, unsigned& nloc, unsigned& nx) {
  const unsigned G = gridDim.x * gridDim.y * gridDim.z;
  unsigned sum, cnt, mine, sp = 0u;
  for (;;) {
    sum = 0u; cnt = 0u; mine = 0u;
#pragma unroll
    for (unsigned j = 0; j < 16; ++j) { const unsigned c = xb_ld(&bar[XB_XCNT(j)]); sum += c; cnt += (c > 0u) ? 1u : 0u; mine = (j == x) ? c : mine; }
    if (sum == G) break;
    __builtin_amdgcn_s_sleep(1);
    if ((++sp & 255u) == 0u) { if (xb_ld(&bar[XB_TMO])) break; if (sp > XB_SPIN_CAP) { atomicAdd(&bar[XB_TMO], 1u); break; } }
  }
  nloc = mine > 0u ? mine : 1u; nx = cnt > 0u ? cnt : 1u;
}
DI void xcd_barrier(const XcdBarrier& b) {
  asm volatile("s_waitcnt vmcnt(0)" ::: "memory");
  __syncthreads();
  if (threadIdx.x == 0) {
    unsigned* bar = b.bar;
    __builtin_amdgcn_s_waitcnt(0);
    unsigned nloc = b.st[0], nx = b.st[1];
    if (nloc == 0u) { xcd_barrier_complete(bar, b.x, nloc, nx); b.st[0] = nloc; b.st[1] = nx; }
    const unsigned old = xb_add(&bar[XB_XSUB(b.x)], 1u);
    const unsigned gen = old / nloc;
    if (old + 1u == (gen + 1u) * nloc) {
      __builtin_amdgcn_fence(__ATOMIC_RELEASE, "agent");
      asm volatile("s_waitcnt vmcnt(0)" ::: "memory");
      const unsigned og = xb_add(&bar[XB_TOP], 1u);
      const unsigned tg = og / nx;
      if (og + 1u == (tg + 1u) * nx) xb_add(&bar[XB_TOPGEN], 1u);
      else XB_SPIN(xb_ld(&bar[XB_TOPGEN]) == tg, bar);
      __builtin_amdgcn_fence(__ATOMIC_ACQUIRE, "agent");
      xb_add(&bar[XB_XGEN(b.x)], 1u);
      asm volatile("s_waitcnt vmcnt(0)" ::: "memory");
    } else {
      XB_SPIN(xb_ld(&bar[XB_XGEN(b.x)]) == gen, bar);
      __builtin_amdgcn_fence(__ATOMIC_ACQUIRE, "agent");
      asm volatile("s_waitcnt vmcnt(0)" ::: "memory");
    }
  }
  __syncthreads();
}

constexpr int DYN_LDS = 2 * G_STAGE;
__global__ void __launch_bounds__(512, 2) hybrid_fwd(Params P) {
  extern __shared__ __attribute__((aligned(16))) char smem[];
  __shared__ uint4 xb_words;
  if (threadIdx.x == 0) xb_words = make_uint4(0u, 0u, 0u, 0u);
  __syncthreads();
  const XcdBarrier xb = xcd_barrier_post((unsigned*)(P.ws + OFF_BAR), (volatile LAS unsigned*)&xb_words);
  if (P.out == nullptr) cg::this_grid().sync();
  for (int li = 0; li < NLAYER; ++li) {
    phase1(P, li, smem); xcd_barrier(xb);
    phase2(P, li, smem); xcd_barrier(xb);
    phase3(P, smem); xcd_barrier(xb);
    phase4(P, li, smem); xcd_barrier(xb);
    phase5(P, smem); xcd_barrier(xb);
    phase6(P, li, smem); xcd_barrier(xb);
    phase7(P, li, smem); xcd_barrier(xb);
    phase9(P, li, smem); xcd_barrier(xb);
  }
}

extern "C" void kernel_launch(void* const* d_in, const int* in_sizes, int n_in, void* d_out, int out_size, void* d_ws, size_t ws_size,
                              hipStream_t stream) {
  static int grid_blocks = 0;
  if (!grid_blocks) {
    int dev = 0, cus = 0, per_cu = 0;
    hipGetDevice(&dev);
    hipDeviceGetAttribute(&cus, hipDeviceAttributeMultiprocessorCount, dev);
    hipFuncSetAttribute((const void*)hybrid_fwd, hipFuncAttributeMaxDynamicSharedMemorySize, DYN_LDS);
    hipOccupancyMaxActiveBlocksPerMultiprocessor(&per_cu, hybrid_fwd, NT, DYN_LDS);
    per_cu = 1;
    grid_blocks = cus * per_cu;
  }
  if (ws_size < WS_TOTAL) fprintf(stderr, "workspace too small: %zu < %zu\n", ws_size, (size_t)WS_TOTAL);
  Params P{};
  const float** pp = (const float**)&P;
  for (int i = 0; i < 29; ++i) pp[i] = (const float*)d_in[i];
  P.out = (float*)d_out;
  P.ws = (char*)d_ws;
  hipMemsetAsync((char*)d_ws + OFF_BAR, 0, 4096 * 4, stream);
  void* args[] = {&P};
  hipError_t e = hipLaunchCooperativeKernel((void*)hybrid_fwd, dim3(grid_blocks), dim3(NT), args, DYN_LDS, stream);
  if (e != hipSuccess) fprintf(stderr, "cooperative launch failed: %s (grid %d)\n", hipGetErrorString(e), grid_blocks);
}
```
